# Optimizing an MI355X kernel written in HIP

```python
import jax, jax.numpy as jnp
from jax import lax
import numpy as np

D_MODEL = 1024
BATCH = 8
SEQ = 4096
DEPTH = 1

CHUNK = 64
MEM_LEN = 256
GLA_HEADS = 4
GLA_DK = D_MODEL // 2
GLA_DV = D_MODEL
GLA_HDK = GLA_DK // GLA_HEADS
GLA_HDV = GLA_DV // GLA_HEADS
GLA_GATE_RANK = 16
GLA_GATE_TEMP = 16.0
POOL_WINDOWS = (2, 4, 8, 16)
POOL_GROUPS = len(POOL_WINDOWS)
POOL_WIDTH = D_MODEL // 2
POOL_GROUP_DIM = POOL_WIDTH // POOL_GROUPS
XA_HEADS = 4
XA_HEAD_DIM = 128
XA_WIDTH = XA_HEADS * XA_HEAD_DIM
N_BRANCH = 3
D_FF = 2816
EPS = 1e-6

IN_SPLITS = (GLA_DK, GLA_DK, GLA_DV, GLA_DV, GLA_GATE_RANK, POOL_WIDTH, XA_WIDTH, N_BRANCH * D_MODEL)
IN_WIDTH = sum(IN_SPLITS)

kernel_name = "hybrid_gla_pool_memxattn_macaron_block"


def rms_norm(x, g):
    xf = x.astype(jnp.float32)
    y = xf * lax.rsqrt(jnp.mean(xf * xf, axis=-1, keepdims=True) + EPS)
    return (y * g.astype(jnp.float32)).astype(x.dtype)


def swiglu(h, w_in, w_out):
    a, b = jnp.split(h @ w_in, 2, axis=-1)
    return (jax.nn.silu(a) * b) @ w_out


def gla_chunked(q, k, v, log_a):
    B, S = q.shape[0], q.shape[1]
    nc = S // CHUNK

    def to_chunks(t):
        return t.reshape(B, nc, CHUNK, GLA_HEADS, t.shape[-1]).transpose(1, 0, 3, 2, 4)

    qc, kc, vc = to_chunks(q), to_chunks(k), to_chunks(v)
    b = jnp.cumsum(to_chunks(log_a.astype(jnp.float32)), axis=3)
    b_end = b[:, :, :, -1:, :]
    kt = (kc.astype(jnp.float32) * jnp.exp(b_end - b)).astype(v.dtype)
    decay = jnp.exp(b_end[:, :, :, 0, :]).astype(v.dtype)

    def step(state, inp):
        q_c, k_c, v_c, d_c = inp
        state = d_c[..., None] * state + jnp.einsum('bhck,bhcv->bhkv', k_c, v_c)
        o = jnp.einsum('bhck,bhkv->bhcv', q_c, state)
        return state, o

    s0 = jnp.zeros((B, GLA_HEADS, GLA_HDK, GLA_HDV), v.dtype)
    _, o = lax.scan(step, s0, (qc, kt, vc, decay))
    return o.transpose(1, 0, 3, 2, 4).reshape(B, S, GLA_DV)


def multiscale_pool(p, w_pool, pool_scale):
    B, S, _ = p.shape
    pg = p.reshape(B, S, POOL_GROUPS, POOL_GROUP_DIM).astype(jnp.float32)
    c0 = jnp.concatenate([jnp.zeros((B, 1, POOL_GROUPS, POOL_GROUP_DIM), jnp.float32),
                          jnp.cumsum(pg, axis=1)], axis=1)
    pos = jnp.arange(1, S + 1, dtype=jnp.float32)
    outs = []
    for g, w in enumerate(POOL_WINDOWS):
        cg = c0[:, :, g]
        lag = jnp.concatenate([jnp.zeros((B, w - 1, POOL_GROUP_DIM), jnp.float32), cg[:, :S + 1 - w]], axis=1)
        cnt = jnp.minimum(pos, float(w))[None, :, None]
        outs.append((cg[:, 1:] - lag) / cnt - pg[:, :, g])
    mixed = jnp.stack(outs, axis=2).astype(p.dtype)
    y = jnp.einsum('bsgc,gcd->bsgd', mixed, w_pool).reshape(B, S, POOL_WIDTH)
    return y * pool_scale


def memory_cross_attention(xq, mem_n, w_mem_kv):
    B, S, _ = xq.shape
    M = mem_n.shape[1]
    q = xq.reshape(B, S, XA_HEADS, XA_HEAD_DIM)
    k, v = jnp.split(mem_n @ w_mem_kv, 2, axis=-1)
    k = k.reshape(B, M, XA_HEADS, XA_HEAD_DIM)
    v = v.reshape(B, M, XA_HEADS, XA_HEAD_DIM)
    s = jnp.einsum('bshd,bmhd->bhsm', q, k).astype(jnp.float32) * (XA_HEAD_DIM ** -0.5)
    pr = jax.nn.softmax(s, axis=-1).astype(v.dtype)
    return jnp.einsum('bhsm,bmhd->bshd', pr, v).reshape(B, S, XA_WIDTH)


def token_mixing(h, mem, w_in, w_fu, b_f, gla_norm_g, w_pool, pool_scale, mem_norm_g, w_mem_kv,
                 w_up_gla, w_up_pool, w_up_xattn, w_o):
    B, S, _ = h.shape
    idx = np.cumsum(IN_SPLITS)[:-1].tolist()
    q, k, v, g_out, f_low, p_in, xq, gates = jnp.split(h @ w_in, idx, axis=-1)
    q = q.reshape(B, S, GLA_HEADS, GLA_HDK) * (GLA_HDK ** -0.5)
    k = k.reshape(B, S, GLA_HEADS, GLA_HDK)
    v = v.reshape(B, S, GLA_HEADS, GLA_HDV)
    f = (f_low @ w_fu + b_f).astype(jnp.float32)
    log_a = (jax.nn.log_sigmoid(f) / GLA_GATE_TEMP).reshape(B, S, GLA_HEADS, GLA_HDK)
    o = gla_chunked(q, k, v, log_a).reshape(B, S, GLA_HEADS, GLA_HDV)
    o = rms_norm(o, gla_norm_g.reshape(GLA_HEADS, GLA_HDV)).reshape(B, S, GLA_DV)
    y_a = (o * jax.nn.silu(g_out)) @ w_up_gla
    y_b = multiscale_pool(p_in, w_pool, pool_scale) @ w_up_pool
    y_c = memory_cross_attention(xq, rms_norm(mem, mem_norm_g), w_mem_kv) @ w_up_xattn
    gt = jax.nn.sigmoid(gates.reshape(B, S, N_BRANCH, D_MODEL))
    merged = gt[:, :, 0] * y_a + gt[:, :, 1] * y_b + gt[:, :, 2] * y_c
    return merged @ w_o


def setup_inputs(seed: int = 0) -> dict:
    key = jax.random.key(seed)
    ks = jax.random.split(key, 32)
    L = DEPTH

    def dense(k, shape, fan_in):
        return jax.random.normal(k, shape, jnp.float32) * (fan_in ** -0.5)

    def gain(k, n):
        return 1.0 + 0.02 * jax.random.normal(k, (L, n), jnp.float32)

    return {
        "x": jax.random.normal(ks[0], (BATCH, SEQ, D_MODEL), jnp.float32),
        "mem": jax.random.normal(ks[1], (BATCH, MEM_LEN, D_MODEL), jnp.float32),
        "ffn1_pre_g": gain(ks[2], D_MODEL),
        "ffn1_w_in": dense(ks[3], (L, D_MODEL, 2 * D_FF), D_MODEL),
        "ffn1_w_out": dense(ks[4], (L, D_FF, D_MODEL), D_FF),
        "ffn1_post_g": gain(ks[5], D_MODEL),
        "mix_pre_g": gain(ks[6], D_MODEL),
        "w_in": dense(ks[7], (L, D_MODEL, IN_WIDTH), D_MODEL),
        "w_fu": dense(ks[8], (L, GLA_GATE_RANK, GLA_DK), GLA_GATE_RANK),
        "b_f": 0.1 * jax.random.normal(ks[9], (L, GLA_DK), jnp.float32),
        "gla_norm_g": gain(ks[10], GLA_DV),
        "w_pool": dense(ks[11], (L, POOL_GROUPS, POOL_GROUP_DIM, POOL_GROUP_DIM), POOL_GROUP_DIM),
        "pool_scale": gain(ks[12], POOL_WIDTH),
        "mem_norm_g": gain(ks[13], D_MODEL),
        "w_mem_kv": dense(ks[14], (L, D_MODEL, 2 * XA_WIDTH), D_MODEL),
        "w_up_gla": dense(ks[15], (L, GLA_DV, D_MODEL), GLA_DV),
        "w_up_pool": dense(ks[16], (L, POOL_WIDTH, D_MODEL), POOL_WIDTH),
        "w_up_xattn": dense(ks[17], (L, XA_WIDTH, D_MODEL), XA_WIDTH),
        "w_o": dense(ks[18], (L, D_MODEL, D_MODEL), D_MODEL),
        "mix_post_g": gain(ks[19], D_MODEL),
        "ffn2_pre_g": gain(ks[20], D_MODEL),
        "ffn2_w_in": dense(ks[21], (L, D_MODEL, 2 * D_FF), D_MODEL),
        "ffn2_w_out": dense(ks[22], (L, D_FF, D_MODEL), D_FF),
        "ffn2_post_g": gain(ks[23], D_MODEL),
        "final_g": gain(ks[24], D_MODEL),
    }


def reference(x, mem, ffn1_pre_g, ffn1_w_in, ffn1_w_out, ffn1_post_g, mix_pre_g, w_in, w_fu, b_f,
              gla_norm_g, w_pool, pool_scale, mem_norm_g, w_mem_kv, w_up_gla, w_up_pool, w_up_xattn,
              w_o, mix_post_g, ffn2_pre_g, ffn2_w_in, ffn2_w_out, ffn2_post_g, final_g):
    for l in range(DEPTH):
        x = x + 0.5 * rms_norm(swiglu(rms_norm(x, ffn1_pre_g[l]), ffn1_w_in[l], ffn1_w_out[l]), ffn1_post_g[l])
        h = rms_norm(x, mix_pre_g[l])
        y = token_mixing(h, mem, w_in[l], w_fu[l], b_f[l], gla_norm_g[l], w_pool[l], pool_scale[l],
                         mem_norm_g[l], w_mem_kv[l], w_up_gla[l], w_up_pool[l], w_up_xattn[l], w_o[l])
        x = x + rms_norm(y, mix_post_g[l])
        x = x + 0.5 * rms_norm(swiglu(rms_norm(x, ffn2_pre_g[l]), ffn2_w_in[l], ffn2_w_out[l]), ffn2_post_g[l])
        x = rms_norm(x, final_g[l])
    return x
```

```cpp
#include <hip/hip_runtime.h>
#include <hip/hip_cooperative_groups.h>
#include <cstdio>
#include <cstdint>
#define MK_MODE 0
namespace pg8 {
#define PG8_LAS __attribute__((address_space(3)))
typedef unsigned short bf16_t;
typedef short bf16x8 __attribute__((ext_vector_type(8)));
typedef float f32x4 __attribute__((ext_vector_type(4)));
typedef unsigned u32x4 __attribute__((ext_vector_type(4)));
constexpr int BM = 256, BK = 64, HALF = 128, HTB = HALF * BK * 2  , STAGE_BYTES = 8 * HTB, NXCD = 8, WGM = 8;

__host__ __device__ __forceinline__ int lds_byte(int r, int c) { const int st = (r >> 4) * 2 + (c >> 5), rr = r & 15, cc = c & 31, ob = rr * 64 + cc * 2; return st * 1024 + (ob ^ (((ob >> 9) & 1) << 5)); }
__host__ __device__ __forceinline__ void stage_rc(int b, int& R, int& C) { const int st = b / 1024, sb = b % 1024, swz = sb ^ (((sb >> 9) & 1) << 5); R = (st >> 1) * 16 + swz / 64; C = (st & 1) * 32 + (swz % 64) / 2; }
__host__ __device__ __forceinline__ int perm32(int rho) { const int n = rho >> 4, i = rho & 15; return 8 * (i >> 2) + 4 * n + (i & 3); }

struct Unit { int pm, pn; };
struct Gemm { const bf16_t* A; const bf16_t* Bt; int M, N, K; };

struct StaticOrder {
    int nM, nN, nwg, G, c;
    __host__ __device__ void init(int M, int N, int G_, int c_) { nM = M / BM; nN = N / BM; nwg = nM * nN; G = G_; c = c_; }
    __host__ __device__ bool next(int i, Unit& u) const {
        const long L = (long)i * G + c; if (L >= nwg) return false;
        int wgid = (int)L; { const int q = nwg / NXCD, r = nwg % NXCD, xcd = wgid % NXCD, off = wgid / NXCD; wgid = (xcd < r ? xcd * (q + 1) : r * (q + 1) + (xcd - r) * q) + off; }
        const int nig = WGM * nN, gid = wgid / nig, fm = gid * WGM, gsz = (nM - fm) < WGM ? (nM - fm) : WGM;
        u.pm = fm + ((wgid % nig) % gsz); u.pn = (wgid % nig) / gsz; return true;
    }
    __device__ __forceinline__ void a_ready(const Unit&) const {}
    __device__ __forceinline__ void done(const Unit&) const {}
};


template <class Epi, class Sched, bool ALIGN_EPI = false, bool SP2 = false>
__device__ __forceinline__ void gemm_phase(PG8_LAS unsigned char* lds, const Gemm g, const Sched& S, const Epi& E) {
    const int tid = threadIdx.x, wid = __builtin_amdgcn_readfirstlane(tid >> 6), lane = tid & 63, wr = wid >> 2, wc = wid & 3, fr = lane & 15, fq = lane >> 4;
    const int K = g.K, nt = K / BK;
    unsigned voffA[2], voffB[2];
#pragma unroll
    for (int i = 0; i < 2; ++i) { int R, C; stage_rc(tid * 16 + i * 8192, R, C); const int Rb = Epi::PERM ? ((R & ~31) + perm32(R & 31)) : R;
        voffA[i] = (unsigned)(R * K + C) * 2u; voffB[i] = (unsigned)(Rb * K + C) * 2u; }
    const size_t kstep = (size_t)(BK * 2);
    const size_t hstep = (size_t)HALF * K * 2;
    const size_t tstep = 2 * hstep;
    const unsigned ldsw = (unsigned)wid * 1024u;
    const int aoff = lds_byte(wr * 64 + fr, fq * 8), boff = lds_byte(wc * 32 + fr, fq * 8);
#define PG8_SA(b, h) (((b) * 2 + (h)) * HTB)
#define PG8_SB(b, h) ((4 + (b) * 2 + (h)) * HTB)
#define PG8_STAGE(bufoff, gbase, voff) do { _Pragma("unroll") for (int _i = 0; _i < 2; ++_i) \
        __builtin_amdgcn_global_load_lds((const unsigned*)((const char*)(gbase) + (voff)[_i]), (PG8_LAS unsigned*)(lds + (bufoff) + ldsw + _i * 8192), 16, 0, 0); } while (0)
#define PG8_LDA(dst, b, h) do { _Pragma("unroll") for (int m = 0; m < 4; ++m) _Pragma("unroll") for (int k = 0; k < 2; ++k) dst[m][k] = *(const PG8_LAS bf16x8*)(lds + PG8_SA(b, h) + aoff + m * 2048 + k * 1024); } while (0)
#define PG8_LDB(dst, b, h) do { _Pragma("unroll") for (int n = 0; n < 2; ++n) _Pragma("unroll") for (int k = 0; k < 2; ++k) dst[n][k] = *(const PG8_LAS bf16x8*)(lds + PG8_SB(b, h) + boff + n * 2048 + k * 1024); } while (0)
#define PG8_MMA(ai, bj, At, Bt) do { __builtin_amdgcn_s_setprio(1); _Pragma("unroll") for (int m = 0; m < 4; ++m) _Pragma("unroll") for (int n = 0; n < 2; ++n) _Pragma("unroll") for (int k = 0; k < 2; ++k) \
        acc[ai][bj][m][n] = __builtin_amdgcn_mfma_f32_16x16x32_bf16(Bt[n][k], At[m][k], acc[ai][bj][m][n], 0, 0, 0); __builtin_amdgcn_s_setprio(0); } while (0)
#define PG8_WAIT_V(n) asm volatile("s_waitcnt vmcnt(" #n ")" ::: "memory")
#define PG8_WAIT_L(n) asm volatile("s_waitcnt lgkmcnt(" #n ")" ::: "memory")
#define PG8_BAR __builtin_amdgcn_s_barrier()
#define PG8_SCHED __builtin_amdgcn_sched_barrier(0)
    Unit cur, nxt; int ui = 0;
    if (!S.next(0, cur)) return;
    f32x4 acc[2][2][4][2];
#pragma unroll
    for (int a = 0; a < 2; ++a)
#pragma unroll
        for (int b = 0; b < 2; ++b)
#pragma unroll
            for (int m = 0; m < 4; ++m)
#pragma unroll
                for (int n = 0; n < 2; ++n) acc[a][b][m][n] = (f32x4){0.f, 0.f, 0.f, 0.f};
    bf16x8 At[4][2], B0[2][2], B1[2][2];
    const char* cA = (const char*)g.A + (size_t)cur.pm * tstep; const char* cB = (const char*)g.Bt + (size_t)cur.pn * tstep;
    S.a_ready(cur);
    if constexpr (SP2) {
        PG8_STAGE(PG8_SB(0, 0), cB, voffB); PG8_STAGE(PG8_SB(0, 1), cB + hstep, voffB); PG8_STAGE(PG8_SA(0, 0), cA, voffA); PG8_STAGE(PG8_SA(0, 1), cA + hstep, voffA);
        if (wr == 1) PG8_BAR;
        PG8_WAIT_V(2); PG8_BAR;
        PG8_STAGE(PG8_SB(1, 0), cB + kstep, voffB); PG8_STAGE(PG8_SA(1, 0), cA + kstep, voffA); PG8_STAGE(PG8_SB(1, 1), cB + hstep + kstep, voffB);
        PG8_WAIT_V(6); PG8_BAR;
    } else {
        PG8_STAGE(PG8_SB(0, 0), cB, voffB); PG8_STAGE(PG8_SA(0, 0), cA, voffA); PG8_STAGE(PG8_SB(0, 1), cB + hstep, voffB); PG8_STAGE(PG8_SA(0, 1), cA + hstep, voffA);
        if (wr == 1) PG8_BAR;
        PG8_WAIT_V(4); PG8_BAR;
        PG8_STAGE(PG8_SB(1, 0), cB + kstep, voffB); PG8_STAGE(PG8_SA(1, 0), cA + kstep, voffA); PG8_STAGE(PG8_SB(1, 1), cB + hstep + kstep, voffB);
        PG8_WAIT_V(6); PG8_BAR;
    }
    for (;;) {
        const bool has_next = S.next(ui + 1, nxt);
        const char* nA = has_next ? (const char*)g.A + (size_t)nxt.pm * tstep : cA; const char* nB = has_next ? (const char*)g.Bt + (size_t)nxt.pn * tstep : cB;
        for (int t = 0; t < nt; t += 2) {
            const bool last = (t == nt - 2);
            if constexpr (Epi::KHOOK) { if (Epi::is_hook(t)) E.khook(acc, cur, t, wr, wc, fr, fq); }
            const char* a1 = cA + (size_t)(t + 1) * kstep;
            const char* a2 = last ? nA : cA + (size_t)(t + 2) * kstep; const char* b2 = last ? nB : cB + (size_t)(t + 2) * kstep;
            const char* a3 = a2 + kstep; const char* b3 = b2 + kstep;
            if (last && has_next) S.a_ready(nxt);
            if constexpr (SP2) {
            PG8_LDB(B0, 0, 0); PG8_LDB(B1, 0, 1); PG8_SCHED; PG8_LDA(At, 0, 0); PG8_STAGE(PG8_SA(1, 1), a1 + hstep, voffA);
            PG8_WAIT_V(8); PG8_WAIT_L(0); PG8_BAR; PG8_MMA(0, 0, At, B0); PG8_MMA(0, 1, At, B1); PG8_BAR; PG8_SCHED;
            PG8_LDA(At, 0, 1); PG8_STAGE(PG8_SB(0, 0), b2, voffB); PG8_STAGE(PG8_SB(0, 1), b2 + hstep, voffB); PG8_STAGE(PG8_SA(0, 0), a2, voffA);
            PG8_WAIT_V(8); PG8_WAIT_L(0); PG8_BAR; PG8_MMA(1, 0, At, B0); PG8_MMA(1, 1, At, B1); PG8_BAR; PG8_SCHED;
            PG8_LDB(B0, 1, 0); PG8_LDB(B1, 1, 1); PG8_SCHED; PG8_LDA(At, 1, 0); PG8_STAGE(PG8_SA(0, 1), a2 + hstep, voffA);
            PG8_WAIT_V(8); PG8_WAIT_L(0); PG8_BAR; PG8_MMA(0, 0, At, B0); PG8_MMA(0, 1, At, B1); PG8_BAR; PG8_SCHED;
            PG8_LDA(At, 1, 1); PG8_STAGE(PG8_SB(1, 0), b3, voffB); PG8_STAGE(PG8_SB(1, 1), b3 + hstep, voffB); PG8_STAGE(PG8_SA(1, 0), a3, voffA);
            PG8_WAIT_V(8); PG8_WAIT_L(0); PG8_BAR; PG8_MMA(1, 0, At, B0); PG8_MMA(1, 1, At, B1); PG8_BAR; PG8_SCHED;
            } else {
            PG8_LDB(B0, 0, 0); PG8_SCHED; PG8_LDA(At, 0, 0); PG8_STAGE(PG8_SA(1, 1), a1 + hstep, voffA);
            PG8_WAIT_L(8); PG8_BAR; PG8_WAIT_L(0); PG8_MMA(0, 0, At, B0); PG8_BAR; PG8_SCHED;
            PG8_LDB(B1, 0, 1); PG8_STAGE(PG8_SB(0, 0), b2, voffB);
            PG8_BAR; PG8_WAIT_L(0); PG8_MMA(0, 1, At, B1); PG8_BAR;
            PG8_LDA(At, 0, 1); PG8_STAGE(PG8_SA(0, 0), a2, voffA);
            PG8_BAR; PG8_WAIT_L(0); PG8_MMA(1, 0, At, B0); PG8_BAR; PG8_SCHED;
            PG8_STAGE(PG8_SB(0, 1), b2 + hstep, voffB);
            PG8_WAIT_V(6); PG8_BAR; PG8_MMA(1, 1, At, B1); PG8_BAR;
            PG8_LDB(B0, 1, 0); PG8_SCHED; PG8_LDA(At, 1, 0); PG8_STAGE(PG8_SA(0, 1), a2 + hstep, voffA);
            PG8_WAIT_L(8); PG8_BAR; PG8_WAIT_L(0); PG8_MMA(0, 0, At, B0); PG8_BAR; PG8_SCHED;
            PG8_LDB(B1, 1, 1); PG8_STAGE(PG8_SB(1, 0), b3, voffB);
            PG8_BAR; PG8_WAIT_L(0); PG8_MMA(0, 1, At, B1); PG8_BAR;
            PG8_LDA(At, 1, 1); PG8_STAGE(PG8_SA(1, 0), a3, voffA);
            PG8_BAR; PG8_WAIT_L(0); PG8_MMA(1, 0, At, B0); PG8_BAR; PG8_SCHED;
            PG8_STAGE(PG8_SB(1, 1), b3 + hstep, voffB);
            PG8_WAIT_V(6); PG8_BAR; PG8_MMA(1, 1, At, B1); PG8_BAR;
            }
        }
        if constexpr (ALIGN_EPI) { if (wr == 0) PG8_BAR; }
        asm volatile("s_nop 7\n\ts_nop 7\n\ts_nop 7" ::: "memory");
        if constexpr (!Epi::AFTER_DRAIN) { E(acc, cur, wr, wc, fr, fq); S.done(cur); }
        if (!has_next) break;
#pragma unroll
        for (int a = 0; a < 2; ++a)
#pragma unroll
            for (int b = 0; b < 2; ++b)
#pragma unroll
                for (int m = 0; m < 4; ++m)
#pragma unroll
                    for (int n = 0; n < 2; ++n) acc[a][b][m][n] = (f32x4){0.f, 0.f, 0.f, 0.f};
        cur = nxt; cA = nA; cB = nB; ++ui;
        if constexpr (ALIGN_EPI) { if (wr == 1) PG8_BAR; }
    }
    PG8_WAIT_V(0);
    if constexpr (!ALIGN_EPI) { if (wr == 0) PG8_BAR; }
    PG8_BAR;
    if constexpr (Epi::AFTER_DRAIN) { E.fused(acc, cur, wr, wc, fr, fq, lds, wid, lane); S.done(cur); }
#undef PG8_SA
#undef PG8_SB
#undef PG8_STAGE
#undef PG8_LDA
#undef PG8_LDB
#undef PG8_MMA
#undef PG8_WAIT_V
#undef PG8_WAIT_L
#undef PG8_BAR
#undef PG8_SCHED
}
}
namespace mk {
#define LAS __attribute__((address_space(3)))
typedef unsigned short bf16_t;
typedef short bf16x8 __attribute__((ext_vector_type(8)));
typedef short s16x4 __attribute__((ext_vector_type(4)));
typedef float f32x4 __attribute__((ext_vector_type(4)));
typedef float f32x16 __attribute__((ext_vector_type(16)));
typedef unsigned u32x4 __attribute__((ext_vector_type(4)));
typedef unsigned u32x2 __attribute__((ext_vector_type(2)));
using pg8::Unit;

constexpr int T = 32768, D = 1024, FF = 2816, NB = 8, SEQ = 4096;
constexpr float EPS = 1e-6f, LOG2E = 1.4426950408889634f, LN2 = 0.6931471805599453f;
constexpr float QSCALE = 0.08838834764831845f, XSCALE = 0.08838834764831845f * 1.4426950408889634f;
constexpr size_t MiB = 1u << 20;
constexpr size_t WS_CTL = 0, CTL_BYTES = 65536;
constexpr size_t WS_FLOW = 1 * MiB;
constexpr size_t WS_DEC = 2 * MiB;
constexpr size_t WS_OSS = 3 * MiB;
constexpr size_t WS_MEMN = 11 * MiB;
constexpr size_t WS_KM = 15 * MiB;
constexpr size_t WS_VMT = 17 * MiB;
constexpr size_t WS_WFU = 19 * MiB;
constexpr size_t WS_WF = 19 * MiB + 65536;
constexpr size_t WS_W1A = 20 * MiB, WS_W1B = 31 * MiB + 512 * 1024, WS_W2A = 37 * MiB + 512 * 1024, WS_W2B = 48 * MiB + 512 * 1024;
constexpr size_t WS_WIN = 54 * MiB + 512 * 1024, WS_WUP = 69 * MiB, WS_WO = 73 * MiB, WS_WMKV = 75 * MiB, WS_WPOOL = 77 * MiB;
constexpr size_t WS_HN = 78 * MiB;
constexpr size_t WS_M = 142 * MiB;
constexpr size_t WS_Q = WS_M, WS_KT = WS_M + 32 * MiB, WS_VT = WS_M + 64 * MiB, WS_PIN = WS_M + 128 * MiB, WS_XQ = WS_M + 160 * MiB;
constexpr size_t WS_A2 = 334 * MiB;
constexpr size_t WS_END = 462 * MiB;
static_assert(WS_W1A + (size_t)5632 * 1024 * 2 <= WS_W1B && WS_W1B + (size_t)1024 * 2816 * 2 <= WS_W2A && WS_W2A + (size_t)5632 * 1024 * 2 <= WS_W2B &&
              WS_W2B + (size_t)1024 * 2816 * 2 <= WS_WIN && WS_WIN + (size_t)7168 * 1024 * 2 <= WS_WUP && WS_WUP + (size_t)1024 * 2048 * 2 <= WS_WO && WS_WPOOL + 131072 <= WS_HN, "ws map");

constexpr int LDS_BYTES = 163840;
constexpr int LDSCTL_OFF = 131072;
constexpr int CW_BAR = 4096;
constexpr int NTHREADS = 512;

__device__ __forceinline__ unsigned cvt_pk_bf16(float lo, float hi) { unsigned r; asm volatile("s_nop 0\n\tv_cvt_pk_bf16_f32 %0, %1, %2" : "=v"(r) : "v"(lo), "v"(hi)); return r; }
typedef __bf16 bf16x2_t __attribute__((ext_vector_type(2)));
typedef float f32x2_t __attribute__((ext_vector_type(2)));
__device__ __forceinline__ unsigned cvt_pk_bf16_c(float lo, float hi) { const f32x2_t v = {lo, hi}; return __builtin_bit_cast(unsigned, __builtin_convertvector(v, bf16x2_t)); }
__device__ __forceinline__ float bflo(unsigned w) { return __uint_as_float(w << 16); }
__device__ __forceinline__ float bfhi(unsigned w) { return __uint_as_float(w & 0xffff0000u); }
__device__ __forceinline__ float ex2(float x) { return __builtin_amdgcn_exp2f(x); }
__device__ __forceinline__ float rcp(float x) { return __builtin_amdgcn_rcpf(x); }
__device__ __forceinline__ float silu(float a) { return a * rcp(1.f + ex2(-a * LOG2E)); }
__device__ __forceinline__ float sigm(float a) { return rcp(1.f + ex2(-a * LOG2E)); }
__device__ __forceinline__ float wave_sum(float v) {
#pragma unroll
    for (int o = 1; o < 64; o <<= 1) v += __shfl_xor(v, o);
    return v;
}
__device__ __forceinline__ bf16x8 ld16(const bf16_t* p) { return *(const bf16x8*)p; }
__device__ __forceinline__ bf16x8 cat8(s16x4 a, s16x4 b) { return __builtin_shufflevector(a, b, 0, 1, 2, 3, 4, 5, 6, 7); }
__device__ __forceinline__ bf16x8 as_bf16x8(u32x4 w) { return __builtin_bit_cast(bf16x8, w); }
__device__ __forceinline__ f32x4 mfma16(bf16x8 a, bf16x8 b, f32x4 c) { return __builtin_amdgcn_mfma_f32_16x16x32_bf16(a, b, c, 0, 0, 0); }
__device__ __forceinline__ f32x16 mfma32(bf16x8 a, bf16x8 b, f32x16 c) { return __builtin_amdgcn_mfma_f32_32x32x16_bf16(a, b, c, 0, 0, 0); }
template <int N> __device__ __forceinline__ float row_shr(float x) {
    return __int_as_float(__builtin_amdgcn_update_dpp(0, __float_as_int(x), 0x110 + N, 0xf, 0xf, true));
}

typedef f32x4 Acc[2][2][4][2];

struct EpiYbf {
    static constexpr bool PERM = true, AFTER_DRAIN = false, KHOOK = false; static constexpr int KH0 = -1, KH1 = -1;
    bf16_t* Yb;
    __device__ __forceinline__ void operator()(Acc& acc, const Unit& u, int wr, int wc, int fr, int fq) const {
        const int row0 = u.pm * 256 + wr * 64 + fr, col0 = u.pn * 256 + wc * 32 + 8 * fq;
#pragma unroll
        for (int ai = 0; ai < 2; ++ai)
#pragma unroll
            for (int m = 0; m < 4; ++m)
#pragma unroll
                for (int bj = 0; bj < 2; ++bj) { const f32x4 a0 = acc[ai][bj][m][0], a1 = acc[ai][bj][m][1];
                    u32x4 w; w.x = cvt_pk_bf16(a0[0], a0[1]); w.y = cvt_pk_bf16(a0[2], a0[3]); w.z = cvt_pk_bf16(a1[0], a1[1]); w.w = cvt_pk_bf16(a1[2], a1[3]);
                    *(u32x4*)(Yb + (size_t)(row0 + ai * 128 + m * 16) * 1024 + col0 + bj * 128) = w; }
    }
};
struct EpiSwiglu {
    static constexpr bool PERM = true, AFTER_DRAIN = false, KHOOK = false; static constexpr int KH0 = -1, KH1 = -1;
    bf16_t* G;
    __device__ __forceinline__ void operator()(Acc& acc, const Unit& u, int wr, int wc, int fr, int fq) const {
        const int row0 = u.pm * 256 + wr * 64 + fr, col0 = u.pn * 128 + wc * 32 + 8 * fq;
#pragma unroll
        for (int ai = 0; ai < 2; ++ai)
#pragma unroll
            for (int m = 0; m < 4; ++m) {
                const f32x4 a0 = acc[ai][0][m][0], a1 = acc[ai][0][m][1], b0 = acc[ai][1][m][0], b1 = acc[ai][1][m][1];
                u32x4 w;
                w.x = cvt_pk_bf16(silu(a0[0]) * b0[0], silu(a0[1]) * b0[1]); w.y = cvt_pk_bf16(silu(a0[2]) * b0[2], silu(a0[3]) * b0[3]);
                w.z = cvt_pk_bf16(silu(a1[0]) * b1[0], silu(a1[1]) * b1[1]); w.w = cvt_pk_bf16(silu(a1[2]) * b1[2], silu(a1[3]) * b1[3]);
                *(u32x4*)(G + (size_t)(row0 + ai * 128 + m * 16) * FF + col0) = w;
            }
    }
};
struct EpiGates {
    static constexpr bool PERM = true, AFTER_DRAIN = false, KHOOK = false; static constexpr int KH0 = -1, KH1 = -1;
    bf16_t* GT;
    __device__ __forceinline__ void operator()(Acc& acc, const Unit& u, int wr, int wc, int fr, int fq) const {
        const int row0 = u.pm * 256 + wr * 64 + fr, col0 = u.pn * 256 + wc * 32 + 8 * fq;
#pragma unroll
        for (int ai = 0; ai < 2; ++ai)
#pragma unroll
            for (int m = 0; m < 4; ++m)
#pragma unroll
                for (int bj = 0; bj < 2; ++bj) {
                    const f32x4 a0 = acc[ai][bj][m][0], a1 = acc[ai][bj][m][1];
                    float v[8];
#pragma unroll
                    for (int j = 0; j < 4; ++j) { v[j] = fmaxf(sigm(a0[j]), 1e-20f); v[4 + j] = fmaxf(sigm(a1[j]), 1e-20f); }
                    u32x4 w; w.x = cvt_pk_bf16(v[0], v[1]); w.y = cvt_pk_bf16(v[2], v[3]); w.z = cvt_pk_bf16(v[4], v[5]); w.w = cvt_pk_bf16(v[6], v[7]);
                    *(u32x4*)(GT + (size_t)(row0 + ai * 128 + m * 16) * 3072 + col0 + bj * 128) = w;
                }
    }
};
struct EpiMerge {
    static constexpr bool PERM = true, AFTER_DRAIN = false, KHOOK = true; static constexpr int KH0 = 16, KH1 = 24;
    static __device__ __forceinline__ bool is_hook(int t) { return t == 4 || t == 8 || t == 12 || t == 16 || t == 24; }
    const bf16_t* GT; bf16_t* MG; const float* RR;
    __device__ __forceinline__ void khook(Acc& acc, const Unit& u, int t, int wr, int wc, int fr, int fq) const {
        int ofr = fr, ofq = fq; asm volatile("" : "+v"(ofr), "+v"(ofq));
        {
            const unsigned rbase = ((unsigned)(u.pm * 256 + wr * 64 + ofr) * 4u + (unsigned)(t >= 16 ? 3 : (t >> 2) - 1)) * 4u;
            if (t != 24) {
                const char* rb = (const char*)RR;
                float f[2][4];
#pragma unroll
                for (int ai = 0; ai < 2; ++ai)
#pragma unroll
                    for (int m = 0; m < 4; ++m) f[ai][m] = *(const float*)(rb + rbase + (unsigned)((ai * 128 + m * 16) * 16));
#pragma unroll
                for (int ai = 0; ai < 2; ++ai)
#pragma unroll
                    for (int m = 0; m < 4; ++m)
#pragma unroll
                        for (int bj = 0; bj < 2; ++bj) { acc[ai][bj][m][0] *= f[ai][m]; acc[ai][bj][m][1] *= f[ai][m]; }
                asm volatile("" ::: "memory");
            }
            if (t < 16) return;
        }
        const unsigned off0 = ((unsigned)(u.pm * 256 + wr * 64 + ofr) * 3072u + (unsigned)(u.pn * 256 + wc * 32 + 8 * ofq) + (t == 16 ? 0u : 1024u)) * 2u;
        const char* gb = (const char*)GT;
#pragma unroll
        for (int ai = 0; ai < 2; ++ai)
#pragma unroll
            for (int m = 0; m < 4; ++m)
#pragma unroll
                for (int bj = 0; bj < 2; ++bj) {
                    const unsigned o = off0 + (unsigned)((ai * 128 + m * 16) * 3072 + bj * 128) * 2u;
                    const u32x4 nu = *(const u32x4*)(gb + o), de = *(const u32x4*)(gb + o + 2048u);
                    f32x4& a0 = acc[ai][bj][m][0]; f32x4& a1 = acc[ai][bj][m][1];
                    a0[0] *= bflo(nu.x) * rcp(bflo(de.x)); a0[1] *= bfhi(nu.x) * rcp(bfhi(de.x)); a0[2] *= bflo(nu.y) * rcp(bflo(de.y)); a0[3] *= bfhi(nu.y) * rcp(bfhi(de.y));
                    a1[0] *= bflo(nu.z) * rcp(bflo(de.z)); a1[1] *= bfhi(nu.z) * rcp(bfhi(de.z)); a1[2] *= bflo(nu.w) * rcp(bflo(de.w)); a1[3] *= bfhi(nu.w) * rcp(bfhi(de.w));
                    asm volatile("" ::: "memory"); }
    }
    __device__ __forceinline__ void operator()(Acc& acc, const Unit& u, int wr, int wc, int fr, int fq) const {
        int ofr = fr, ofq = fq; asm volatile("" : "+v"(ofr), "+v"(ofq));
        const unsigned r0 = (unsigned)(u.pm * 256 + wr * 64 + ofr), c0 = (unsigned)(u.pn * 256 + wc * 32 + 8 * ofq);
        const char* gb = (const char*)GT; char* mb = (char*)MG;
#pragma unroll
        for (int ai = 0; ai < 2; ++ai)
#pragma unroll
            for (int m = 0; m < 4; ++m)
#pragma unroll
                for (int bj = 0; bj < 2; ++bj) {
                    const unsigned r = r0 + (unsigned)(ai * 128 + m * 16), cc = c0 + (unsigned)(bj * 128);
                    const u32x4 gc = *(const u32x4*)(gb + (r * 3072u + 2048u + cc) * 2u);
                    const f32x4 a0 = acc[ai][bj][m][0], a1 = acc[ai][bj][m][1];
                    u32x4 w;
                    w.x = cvt_pk_bf16(a0[0] * bflo(gc.x), a0[1] * bfhi(gc.x)); w.y = cvt_pk_bf16(a0[2] * bflo(gc.y), a0[3] * bfhi(gc.y));
                    w.z = cvt_pk_bf16(a1[0] * bflo(gc.z), a1[1] * bfhi(gc.z)); w.w = cvt_pk_bf16(a1[2] * bflo(gc.w), a1[3] * bfhi(gc.w));
                    *(u32x4*)(mb + (r * 1024u + cc) * 2u) = w;
                    asm volatile("" ::: "memory"); }
    }
};
struct EpiInProj {
    static constexpr bool PERM = true, AFTER_DRAIN = false, KHOOK = false; static constexpr int KH0 = -1, KH1 = -1;
    bf16_t *Q, *KT, *VT, *A2, *PIN, *XQ; float* DEC; const bf16_t *FLOW, *WFU; const float* b_f;
    LAS unsigned char* scr;
    __device__ __forceinline__ void tstore(const unsigned (&w)[4][2], bf16_t* base, int colbase, int fr, int fq, int wid) const {
        asm volatile("" : "+v"(fr), "+v"(fq));
        LAS unsigned char* sc = scr + wid * 2304;
#pragma unroll
        for (int m = 0; m < 4; ++m) { LAS unsigned short* p = (LAS unsigned short*)(sc + (4 * fq) * 144 + (16 * m + fr) * 2);
            p[0] = (unsigned short)(w[m][0] & 0xffffu); p[72] = (unsigned short)(w[m][0] >> 16); p[144] = (unsigned short)(w[m][1] & 0xffffu); p[216] = (unsigned short)(w[m][1] >> 16); }
        asm volatile("s_waitcnt lgkmcnt(0)" ::: "memory");
#pragma unroll
        for (int i = 0; i < 2; ++i) { const int p = fr + 16 * fq + 64 * i, ci = p >> 3, part = p & 7;
            const u32x4 v = *(const LAS u32x4*)(sc + ci * 144 + part * 16);
            *(u32x4*)(base + (size_t)(colbase + 8 * (ci >> 2) + (ci & 3)) * 64 + part * 8) = v; }
        asm volatile("s_waitcnt lgkmcnt(0)" ::: "memory");
    }
    template <bool SILU> __device__ __forceinline__ void plain(Acc& acc, const Unit& u, int wr, int wc, int fr, int fq, bf16_t* dst, int ld, int colbase, float sc) const {
        const int row0 = u.pm * 256 + wr * 64 + fr, col0 = colbase + wc * 32 + 8 * fq;
#pragma unroll
        for (int ai = 0; ai < 2; ++ai)
#pragma unroll
            for (int m = 0; m < 4; ++m)
#pragma unroll
                for (int bj = 0; bj < 2; ++bj) {
                    const f32x4 a0 = acc[ai][bj][m][0], a1 = acc[ai][bj][m][1];
                    float v[8];
#pragma unroll
                    for (int j = 0; j < 4; ++j) { v[j] = SILU ? silu(a0[j]) : a0[j] * sc; v[4 + j] = SILU ? silu(a1[j]) : a1[j] * sc; }
                    u32x4 w; w.x = cvt_pk_bf16(v[0], v[1]); w.y = cvt_pk_bf16(v[2], v[3]); w.z = cvt_pk_bf16(v[4], v[5]); w.w = cvt_pk_bf16(v[6], v[7]);
                    *(u32x4*)(dst + (size_t)(row0 + ai * 128 + m * 16) * ld + col0 + bj * 128) = w;
                }
    }
    __device__ __forceinline__ void vtile(Acc& acc, const Unit& u, int wr, int wc, int fr, int fq) const {
        const int h = u.pn - 4, wid = wr * 4 + wc;
#pragma unroll
        for (int ai = 0; ai < 2; ++ai) {
            const int t0 = u.pm * 256 + ai * 128 + wr * 64, b = t0 >> 12, c = (t0 >> 6) & 63;
            bf16_t* base = VT + (size_t)((b * 4 + h) * 64 + c) * 256 * 64;
#pragma unroll
            for (int bj = 0; bj < 2; ++bj)
#pragma unroll
                for (int n = 0; n < 2; ++n) {
                    unsigned w[4][2];
#pragma unroll
                    for (int m = 0; m < 4; ++m) { const f32x4 a = acc[ai][bj][m][n]; w[m][0] = cvt_pk_bf16(a[0], a[1]); w[m][1] = cvt_pk_bf16(a[2], a[3]); }
                    tstore(w, base, bj * 128 + wc * 32 + 4 * n, fr, fq, wid); }
        }
    }
    __device__ __forceinline__ void ktile(Acc& acc, const Unit& u, int wr, int wc, int fr, int fq) const {
        const int lane = threadIdx.x & 63;
        const bf16x8 zero8 = (bf16x8){0, 0, 0, 0, 0, 0, 0, 0};
#pragma unroll
        for (int ai = 0; ai < 2; ++ai) {
            const int t0 = u.pm * 256 + ai * 128 + wr * 64, b = t0 >> 12, c = (t0 >> 6) & 63;
            bf16x8 ff[4];
#pragma unroll
            for (int m = 0; m < 4; ++m) ff[m] = (fq < 2) ? ld16(FLOW + (size_t)(t0 + 16 * m + fr) * 16 + 8 * fq) : zero8;
#pragma unroll
            for (int bj = 0; bj < 2; ++bj) {
                const int h = (u.pn - 2) * 2 + bj;
                bf16_t* ktb = KT + (size_t)((b * 4 + h) * 64 + c) * 128 * 64;
#pragma unroll
                for (int n = 0; n < 2; ++n) {
                    const int cw = h * 128 + wc * 32 + 8 * (fr >> 2) + 4 * n + (fr & 3);
                    const bf16x8 wf = (fq < 2) ? ld16(WFU + (size_t)cw * 16 + 8 * fq) : zero8;
                    const int kk = wc * 32 + 8 * fq + 4 * n;
                    const f32x4 bias = *(const f32x4*)(b_f + h * 128 + kk);
                    f32x4 la[4];
#pragma unroll
                    for (int m = 0; m < 4; ++m) { f32x4 f = mfma16(wf, ff[m], (f32x4){0.f, 0.f, 0.f, 0.f});
#pragma unroll
                        for (int j = 0; j < 4; ++j) { const float x = f[j] + bias[j]; const float e = ex2(-fabsf(x) * LOG2E);
                            la[m][j] = (fminf(x, 0.f) - __log2f(1.f + e) * LN2) * (1.f / 16.f); } }
                    f32x4 run = (f32x4){0.f, 0.f, 0.f, 0.f};
#pragma unroll
                    for (int m = 0; m < 4; ++m)
#pragma unroll
                        for (int j = 0; j < 4; ++j) { float x = la[m][j];
                            x += row_shr<1>(x); x += row_shr<2>(x); x += row_shr<4>(x); x += row_shr<8>(x);
                            const float tot = __int_as_float(__builtin_amdgcn_update_dpp(0, __float_as_int(x), 0x15F, 0xf, 0xf, false));
                            la[m][j] = x + run[j]; run[j] += tot; }
                    unsigned w[4][2];
#pragma unroll
                    for (int m = 0; m < 4; ++m) { const f32x4 a = acc[ai][bj][m][n];
                        w[m][0] = cvt_pk_bf16(a[0] * ex2((run[0] - la[m][0]) * LOG2E), a[1] * ex2((run[1] - la[m][1]) * LOG2E));
                        w[m][1] = cvt_pk_bf16(a[2] * ex2((run[2] - la[m][2]) * LOG2E), a[3] * ex2((run[3] - la[m][3]) * LOG2E)); }
                    tstore(w, ktb, wc * 32 + 4 * n, fr, fq, wr * 4 + wc);
                    if (fr == 0) *(f32x4*)(DEC + (size_t)(b * 64 + c) * 512 + h * 128 + kk) = (f32x4){ex2(run[0] * LOG2E), ex2(run[1] * LOG2E), ex2(run[2] * LOG2E), ex2(run[3] * LOG2E)};
                }
            }
        }
    }
    __device__ __forceinline__ void operator()(Acc& acc, const Unit& u, int wr, int wc, int fr, int fq) const {
        const int pn = u.pn;
        if (pn < 2) plain<false>(acc, u, wr, wc, fr, fq, Q, 512, pn * 256, QSCALE);
        else if (pn < 4) ktile(acc, u, wr, wc, fr, fq);
        else if (pn < 8) vtile(acc, u, wr, wc, fr, fq);
        else if (pn < 12) plain<true>(acc, u, wr, wc, fr, fq, A2, 2048, (pn - 8) * 256, 1.f);
        else if (pn < 14) plain<false>(acc, u, wr, wc, fr, fq, PIN, 512, (pn - 12) * 256, 1.f);
        else plain<false>(acc, u, wr, wc, fr, fq, XQ, 512, (pn - 14) * 256, XSCALE);
    }
};

struct Row { f32x4 v[4]; };
__device__ __forceinline__ Row ld_row(const float* p, int lane) { Row r; const float* q = p + 8 * lane;
    r.v[0] = *(const f32x4*)q; r.v[1] = *(const f32x4*)(q + 4); r.v[2] = *(const f32x4*)(q + 512); r.v[3] = *(const f32x4*)(q + 516); return r; }
__device__ __forceinline__ Row ld_row_nt(const float* p, int lane) { Row r; const f32x4* q = (const f32x4*)(p + 8 * lane);
    r.v[0] = __builtin_nontemporal_load(q); r.v[1] = __builtin_nontemporal_load(q + 1); r.v[2] = __builtin_nontemporal_load(q + 128); r.v[3] = __builtin_nontemporal_load(q + 129); return r; }
__device__ __forceinline__ void st_row(float* p, int lane, const Row& r) { float* q = p + 8 * lane;
    *(f32x4*)q = r.v[0]; *(f32x4*)(q + 4) = r.v[1]; *(f32x4*)(q + 512) = r.v[2]; *(f32x4*)(q + 516) = r.v[3]; }
__device__ __forceinline__ void st_row_nt(float* p, int lane, const Row& r) { f32x4* q = (f32x4*)(p + 8 * lane);
    __builtin_nontemporal_store(r.v[0], q); __builtin_nontemporal_store(r.v[1], q + 1); __builtin_nontemporal_store(r.v[2], q + 128); __builtin_nontemporal_store(r.v[3], q + 129); }
__device__ __forceinline__ Row ld_row_bf(const bf16_t* p, int lane) { Row r; const u32x4 a = __builtin_nontemporal_load((const u32x4*)(p + 8 * lane)), b = __builtin_nontemporal_load((const u32x4*)(p + 512 + 8 * lane));
    r.v[0] = (f32x4){bflo(a.x), bfhi(a.x), bflo(a.y), bfhi(a.y)}; r.v[1] = (f32x4){bflo(a.z), bfhi(a.z), bflo(a.w), bfhi(a.w)};
    r.v[2] = (f32x4){bflo(b.x), bfhi(b.x), bflo(b.y), bfhi(b.y)}; r.v[3] = (f32x4){bflo(b.z), bfhi(b.z), bflo(b.w), bfhi(b.w)}; return r; }
__device__ __forceinline__ float row_ss(const Row& r) { float s = 0.f;
#pragma unroll
    for (int j = 0; j < 4; ++j) s += (r.v[j][0] * r.v[j][0] + r.v[j][1] * r.v[j][1]) + (r.v[j][2] * r.v[j][2] + r.v[j][3] * r.v[j][3]);
    return wave_sum(s); }
__device__ __forceinline__ float rs_of(float ss) { return rsqrtf(ss * (1.f / 1024.f) + EPS); }
__device__ __forceinline__ Row mul_g(const Row& x, float rs, const Row& g) { Row r;
#pragma unroll
    for (int j = 0; j < 4; ++j) r.v[j] = x.v[j] * rs * g.v[j];
    return r; }
__device__ __forceinline__ void st_row_bf(const Row& h, bf16_t* out, int lane, LAS unsigned char* ldsrow) {
    u32x4 a, b; a.x = cvt_pk_bf16(h.v[0][0], h.v[0][1]); a.y = cvt_pk_bf16(h.v[0][2], h.v[0][3]); a.z = cvt_pk_bf16(h.v[1][0], h.v[1][1]); a.w = cvt_pk_bf16(h.v[1][2], h.v[1][3]);
    b.x = cvt_pk_bf16(h.v[2][0], h.v[2][1]); b.y = cvt_pk_bf16(h.v[2][2], h.v[2][3]); b.z = cvt_pk_bf16(h.v[3][0], h.v[3][1]); b.w = cvt_pk_bf16(h.v[3][2], h.v[3][3]);
    *(u32x4*)(out + 8 * lane) = a; *(u32x4*)(out + 512 + 8 * lane) = b;
    if (ldsrow) { *(LAS u32x4*)(ldsrow + 16 * lane) = a; *(LAS u32x4*)(ldsrow + 1024 + 16 * lane) = b; }
}

__device__ __forceinline__ void st_row_bf_nt(const Row& h, bf16_t* out, int lane) {
    u32x4 a, b; a.x = cvt_pk_bf16(h.v[0][0], h.v[0][1]); a.y = cvt_pk_bf16(h.v[0][2], h.v[0][3]); a.z = cvt_pk_bf16(h.v[1][0], h.v[1][1]); a.w = cvt_pk_bf16(h.v[1][2], h.v[1][3]);
    b.x = cvt_pk_bf16(h.v[2][0], h.v[2][1]); b.y = cvt_pk_bf16(h.v[2][2], h.v[2][3]); b.z = cvt_pk_bf16(h.v[3][0], h.v[3][1]); b.w = cvt_pk_bf16(h.v[3][2], h.v[3][3]);
    __builtin_nontemporal_store(a, (u32x4*)(out + 8 * lane)); __builtin_nontemporal_store(b, (u32x4*)(out + 512 + 8 * lane));
}

__device__ __forceinline__ unsigned pk2(float lo, float hi) { return cvt_pk_bf16(lo, hi); }
__device__ __forceinline__ void transpose_item(const float* W, int ldw, int k0, int ns0, bf16_t* WT, int ldt, int dr0, int dk0, LAS float* scr, int lane) {
    f32x4 v[8];
#pragma unroll
    for (int i = 0; i < 8; ++i) { const int kk = (lane >> 3) + 8 * i; v[i] = *(const f32x4*)(W + (size_t)(k0 + kk) * ldw + ns0 + 4 * (lane & 7)); }
#pragma unroll
    for (int i = 0; i < 8; ++i) { const int kk = (lane >> 3) + 8 * i; LAS float* q = scr + kk * 33 + 4 * (lane & 7); q[0] = v[i][0]; q[1] = v[i][1]; q[2] = v[i][2]; q[3] = v[i][3]; }
    asm volatile("s_waitcnt lgkmcnt(0)" ::: "memory");
    const int c = lane & 7;
#pragma unroll
    for (int j = 0; j < 4; ++j) { const int n = (lane >> 3) + 8 * j; const LAS float* s = scr + (8 * c) * 33 + n;
        u32x4 o; o.x = pk2(s[0 * 33], s[1 * 33]); o.y = pk2(s[2 * 33], s[3 * 33]); o.z = pk2(s[4 * 33], s[5 * 33]); o.w = pk2(s[6 * 33], s[7 * 33]);
        *(u32x4*)(WT + (size_t)(dr0 + n) * ldt + dk0 + 8 * c) = o; }
    asm volatile("s_waitcnt lgkmcnt(0)" ::: "memory");
}

struct Ptrs {
    const float* in[25]; float* out; unsigned char* ws; int ph_lo, ph_hi;
};
enum { I_X = 0, I_MEM, I_F1G, I_F1WI, I_F1WO, I_F1PG, I_MIXG, I_WIN, I_WFU, I_BF, I_GLAG, I_WPOOL, I_PSCALE, I_MEMG, I_WMKV, I_WUPG, I_WUPP, I_WUPX, I_WO, I_MIXPG, I_F2G, I_F2WI, I_F2WO, I_F2PG, I_FING };

__device__ __forceinline__ void p0_prologue(const Ptrs& P, LAS unsigned char* lds, int wave, int lane) {
    unsigned char* ws = P.ws;
    LAS float* scr = (LAS float*)(lds + wave * 16384);
    const int gw = blockIdx.x * 8 + wave, NGW = gridDim.x * 8;
    constexpr int I_FA = 16 * 176, I_FB = 44 * 32, I_IN = 16 * 224, I_UG = 16 * 32, I_UP = 8 * 32, I_SQ = 16 * 32, I_PL = 32;
    constexpr int NITEMS = 2 * (I_FA + I_FB) + I_IN + I_UG + 2 * I_UP + 2 * I_SQ + I_PL;
    for (int it = gw; it < NITEMS; it += NGW) {
        int r = it;
#pragma unroll
        for (int f = 0; f < 2; ++f) {
            if (r >= 0 && r < I_FA) { const int kb = r / 176, nb = r % 176, c = 32 * nb; const int dr = c < FF ? 256 * (c / 128) + (c % 128) : 256 * ((c - FF) / 128) + 128 + ((c - FF) % 128);
                transpose_item(P.in[f ? I_F2WI : I_F1WI], 2 * FF, 64 * kb, c, (bf16_t*)(ws + (f ? WS_W2A : WS_W1A)), 1024, dr, 64 * kb, scr, lane); r = -1; }
            if (r >= 0) r -= I_FA;
            if (r >= 0 && r < I_FB) { const int kb = r / 32, nb = r % 32;
                transpose_item(P.in[f ? I_F2WO : I_F1WO], 1024, 64 * kb, 32 * nb, (bf16_t*)(ws + (f ? WS_W2B : WS_W1B)), FF, 32 * nb, 64 * kb, scr, lane); r = -1; }
            if (r >= 0) r -= I_FB;
        }
        if (r < 0) continue;
        if (r < I_IN) { const int kb = r / 224, nb = r % 224, dr = 32 * nb, sc = dr < 3072 ? dr : dr + 16;
            transpose_item(P.in[I_WIN], 7184, 64 * kb, sc, (bf16_t*)(ws + WS_WIN), 1024, dr, 64 * kb, scr, lane); continue; } r -= I_IN;
        if (r < I_UG) { const int kb = r / 32, nb = r % 32; transpose_item(P.in[I_WUPG], 1024, 64 * kb, 32 * nb, (bf16_t*)(ws + WS_WUP), 2048, 32 * nb, 64 * kb, scr, lane); continue; } r -= I_UG;
        if (r < I_UP) { const int kb = r / 32, nb = r % 32; transpose_item(P.in[I_WUPP], 1024, 64 * kb, 32 * nb, (bf16_t*)(ws + WS_WUP), 2048, 32 * nb, 1024 + 64 * kb, scr, lane); continue; } r -= I_UP;
        if (r < I_UP) { const int kb = r / 32, nb = r % 32; transpose_item(P.in[I_WUPX], 1024, 64 * kb, 32 * nb, (bf16_t*)(ws + WS_WUP), 2048, 32 * nb, 1536 + 64 * kb, scr, lane); continue; } r -= I_UP;
        if (r < I_SQ) { const int kb = r / 32, nb = r % 32; transpose_item(P.in[I_WO], 1024, 64 * kb, 32 * nb, (bf16_t*)(ws + WS_WO), 1024, 32 * nb, 64 * kb, scr, lane); continue; } r -= I_SQ;
        if (r < I_SQ) { const int kb = r / 32, nb = r % 32; transpose_item(P.in[I_WMKV], 1024, 64 * kb, 32 * nb, (bf16_t*)(ws + WS_WMKV), 1024, 32 * nb, 64 * kb, scr, lane); continue; } r -= I_SQ;
        { const int g = r / 8, q = r % 8, kb = q / 4, nb = q % 4;
          transpose_item(P.in[I_WPOOL] + g * 16384, 128, 64 * kb, 32 * nb, (bf16_t*)(ws + WS_WPOOL) + g * 16384, 128, 32 * nb, 64 * kb, scr, lane); }
    }
    { const int gt = blockIdx.x * NTHREADS + threadIdx.x, NT = gridDim.x * NTHREADS;
      bf16_t* WF = (bf16_t*)(ws + WS_WF); bf16_t* WFU = (bf16_t*)(ws + WS_WFU);
      for (int i = gt; i < 16384; i += NT) { const int n = i >> 10, k = i & 1023; WF[i] = (bf16_t)(cvt_pk_bf16(P.in[I_WIN][(size_t)k * 7184 + 3072 + n], 0.f) & 0xffffu); }
      for (int i = gt; i < 8192; i += NT) { const int c = i >> 4, r = i & 15; WFU[i] = (bf16_t)(cvt_pk_bf16(P.in[I_WFU][r * 512 + c], 0.f) & 0xffffu); } }
    bf16_t* HN = (bf16_t*)(ws + WS_HN); bf16_t* MEMN = (bf16_t*)(ws + WS_MEMN);
    for (int m = gw; m < T + 2048; m += NGW) {
        if (m < T) { const Row x = ld_row_nt(P.in[I_X] + (size_t)m * 1024, lane); st_row_bf(mul_g(x, rs_of(row_ss(x)), ld_row(P.in[I_F1G], lane)), HN + (size_t)m * 1024, lane, (LAS unsigned char*)nullptr); }
        else { const int mm = m - T; const Row x = ld_row(P.in[I_MEM] + (size_t)mm * 1024, lane); st_row_bf(mul_g(x, rs_of(row_ss(x)), ld_row(P.in[I_MEMG], lane)), MEMN + (size_t)mm * 1024, lane, (LAS unsigned char*)nullptr); }
    }
}

constexpr int MKV_PITCH = 144, MKV_A = 64 * MKV_PITCH, MKV_STAGE = 192 * MKV_PITCH;
__device__ __forceinline__ void memkv_tile(const Ptrs& P, LAS unsigned char* lds, int wave, int lane) {
    unsigned char* ws = P.ws;
    const bf16_t* MEMN = (const bf16_t*)(ws + WS_MEMN); const bf16_t* W = (const bf16_t*)(ws + WS_WMKV);
    bf16_t* KM = (bf16_t*)(ws + WS_KM); bf16_t* VMT = (bf16_t*)(ws + WS_VMT);
    const int li = lane & 31, hh = lane >> 5, tid = threadIdx.x;
    for (int tile = blockIdx.x; tile < 256; tile += gridDim.x) {
        const int tm = tile >> 3, tn = tile & 7, m0 = 64 * tm + 32 * (wave & 1), n0 = 128 * tn + 32 * (wave >> 1);
        const bf16_t* src[3]; unsigned dst[3];
#pragma unroll
        for (int j = 0; j < 3; ++j) { const int p = tid + 512 * j, row = p >> 3, c16 = p & 7;
            src[j] = (row < 64 ? MEMN + (size_t)(64 * tm + row) * 1024 : W + (size_t)(128 * tn + row - 64) * 1024) + 8 * c16;
            dst[j] = (unsigned)(row * MKV_PITCH + 16 * c16); }
        u32x4 r[3];
#pragma unroll
        for (int j = 0; j < 3; ++j) r[j] = *(const u32x4*)(src[j]);
#pragma unroll
        for (int j = 0; j < 3; ++j) *(LAS u32x4*)(lds + dst[j]) = r[j];
        __syncthreads();
        f32x16 acc; for (int i = 0; i < 16; ++i) acc[i] = 0.f;
        const unsigned ao = (unsigned)((32 * (wave & 1) + li) * MKV_PITCH + 16 * hh), wo = (unsigned)(MKV_A + (32 * (wave >> 1) + li) * MKV_PITCH + 16 * hh);
#pragma unroll 1
        for (int kc = 0; kc < 16; ++kc) {
            LAS unsigned char* cur = lds + (kc & 1) * MKV_STAGE; LAS unsigned char* nxt = lds + ((kc + 1) & 1) * MKV_STAGE;
            if (kc + 1 < 16) {
#pragma unroll
                for (int j = 0; j < 3; ++j) r[j] = *(const u32x4*)(src[j] + 64 * (kc + 1)); }
#pragma unroll
            for (int st = 0; st < 4; ++st) { const bf16x8 af = *(const LAS bf16x8*)(cur + ao + 32 * st), wf = *(const LAS bf16x8*)(cur + wo + 32 * st);
                acc = tn < 4 ? mfma32(wf, af, acc) : mfma32(af, wf, acc); }
            if (kc + 1 < 16) {
#pragma unroll
                for (int j = 0; j < 3; ++j) *(LAS u32x4*)(nxt + dst[j]) = r[j]; }
            __syncthreads();
        }
        if (tn < 4) {
            const int m = m0 + li, b = m >> 8, key = m & 255, h = n0 >> 7;
#pragma unroll
            for (int rr = 0; rr < 4; ++rr) { const int d0 = (n0 & 127) + 8 * rr + 4 * hh;
                u32x2 w; w.x = cvt_pk_bf16_c(acc[4 * rr], acc[4 * rr + 1]); w.y = cvt_pk_bf16_c(acc[4 * rr + 2], acc[4 * rr + 3]);
                *(u32x2*)(KM + ((size_t)((b * 4 + h) * 256 + key)) * 128 + d0) = w; }
        } else {
            const int nn = n0 + li - 512, h = nn >> 7, dv = nn & 127;
#pragma unroll
            for (int rr = 0; rr < 4; ++rr) { const int m = m0 + 8 * rr + 4 * hh, b = m >> 8, key = m & 255;
                u32x2 w; w.x = cvt_pk_bf16_c(acc[4 * rr], acc[4 * rr + 1]); w.y = cvt_pk_bf16_c(acc[4 * rr + 2], acc[4 * rr + 3]);
                *(u32x2*)(VMT + ((size_t)((b * 4 + h) * 128 + dv)) * 256 + key) = w; }
        }
    }
}
constexpr int PR_WF = 0, PR_WFP = 2064, PR_ROWS = 16 * 2064;
struct Row2 { Row y[2], x[2]; };
template <int MODE> __device__ __forceinline__ void row_pass(const Ptrs& P, LAS unsigned char* lds, int wave, int lane) {
    unsigned char* ws = P.ws;
    const bf16_t* Yb = (const bf16_t*)(ws + WS_A2); bf16_t* HN = (bf16_t*)(ws + WS_HN);
    const float* xin = P.in[I_X];
    bf16_t* X1B = (bf16_t*)P.out; bf16_t* X2B = (bf16_t*)(ws + WS_A2 + (size_t)64 * MiB);
    const bf16_t* xb = MODE == 2 ? X1B : X2B;
    const Row gp = ld_row(P.in[MODE == 1 ? I_F1PG : (MODE == 2 ? I_MIXPG : I_F2PG)], lane), gn = ld_row(P.in[MODE == 1 ? I_MIXG : (MODE == 2 ? I_F2G : I_FING)], lane);
    const float sc = MODE == 2 ? 1.0f : 0.5f;
    bf16_t* FLOW = (bf16_t*)(ws + WS_FLOW);
    LAS unsigned char* rimg = lds + PR_ROWS + wave * 4096;
    const int fr = lane & 15, fq = lane >> 4;
    if (MODE == 1) {
        const u32x4* src = (const u32x4*)(ws + WS_WF);
        for (int i = threadIdx.x; i < 2048; i += NTHREADS) *(LAS u32x4*)(lds + PR_WF + (i >> 7) * PR_WFP + 16 * (i & 127)) = src[i];
        __syncthreads();
    }
    const int gw = blockIdx.x * 8 + wave, NGW = gridDim.x * 8, NIT = T / 2;
    Row2 cur, nxt;
#pragma unroll
    for (int i = 0; i < 2; ++i) { const size_t row = (size_t)gw * 2 + i; cur.y[i] = ld_row_bf(Yb + row * 1024, lane); cur.x[i] = MODE == 1 ? ld_row_nt(xin + row * 1024, lane) : ld_row_bf(xb + row * 1024, lane); }
    for (int item = gw; item < NIT; item += NGW) {
        const int ni = item + NGW < NIT ? item + NGW : item;
#pragma unroll
        for (int i = 0; i < 2; ++i) { const size_t row = (size_t)ni * 2 + i; nxt.y[i] = ld_row_bf(Yb + row * 1024, lane); nxt.x[i] = MODE == 1 ? ld_row_nt(xin + row * 1024, lane) : ld_row_bf(xb + row * 1024, lane); }
#pragma unroll
        for (int i = 0; i < 2; ++i) { const size_t row = (size_t)item * 2 + i;
            const float rsy = rs_of(row_ss(cur.y[i])) * sc;
#pragma unroll
            for (int j = 0; j < 4; ++j) cur.x[i].v[j] = cur.x[i].v[j] + cur.y[i].v[j] * rsy * gp.v[j];
            const Row h = mul_g(cur.x[i], rs_of(row_ss(cur.x[i])), gn);
            if (MODE == 3) st_row_nt(P.out + row * 1024, lane, h);
            else { st_row_bf_nt(cur.x[i], (MODE == 1 ? X1B : X2B) + row * 1024, lane); st_row_bf(h, HN + row * 1024, lane, MODE == 1 ? rimg + i * 2048 : (LAS unsigned char*)nullptr); }
        }
        if (MODE == 1) {
            asm volatile("s_waitcnt lgkmcnt(0)" ::: "memory");
            f32x4 a = (f32x4){0.f, 0.f, 0.f, 0.f};
#pragma unroll 8
            for (int s2 = 0; s2 < 32; ++s2) { const int k = 32 * s2 + 8 * fq;
                const bf16x8 hf = *(const LAS bf16x8*)(rimg + (fr & 1) * 2048 + k * 2);
                const bf16x8 wf = *(const LAS bf16x8*)(lds + PR_WF + fr * PR_WFP + k * 2);
                a = mfma16(wf, hf, a); }
            if (fr < 2) { u32x2 o; o.x = cvt_pk_bf16_c(a[0], a[1]); o.y = cvt_pk_bf16_c(a[2], a[3]); *(u32x2*)(FLOW + ((size_t)item * 2 + fr) * 16 + 4 * fq) = o; }
            asm volatile("s_waitcnt lgkmcnt(0)" ::: "memory");
        }
        cur = nxt;
    }
}

constexpr int GSTG = 41472, G_KB = 0, G_QB = 16384, G_VB = 32768, G_DB = 40960;
__device__ __forceinline__ void gla_block(const Ptrs& P, LAS unsigned char* lds, int bh, int vq, int wave, int lane) {
    unsigned char* ws = P.ws;
    const int b = bh >> 2, h = bh & 3, li = lane & 15, g = lane >> 4, vg = wave & 3, th = wave >> 2, j16 = 4 * vq + vg;
    const bf16_t* KTb = (const bf16_t*)(ws + WS_KT) + (size_t)bh * 64 * 8192;
    const bf16_t* Qb = (const bf16_t*)(ws + WS_Q) + (size_t)b * SEQ * 512 + h * 128;
    const bf16_t* VTb = (const bf16_t*)(ws + WS_VT) + ((size_t)bh * 64 * 256 + 64 * vq) * 64;
    const float* DCb = (const float*)(ws + WS_DEC) + (size_t)b * 64 * 512 + h * 128;
    float* OSS = (float*)(ws + WS_OSS);
    const int col = h * 256 + 16 * j16 + 4 * g;
    const f32x4 gn = *(const f32x4*)(P.in[I_GLAG] + col);
    bf16_t* arow = (bf16_t*)(ws + WS_A2) + ((size_t)b * SEQ + 32 * th + li) * 2048 + col;
    unsigned ksrc[2], qsrc[2];
#pragma unroll
    for (int i = 0; i < 2; ++i) { const int q = 2 * wave + i;
        { const int kk = 8 * q + (lane >> 3), lc = (lane & 7) ^ (kk & 7); ksrc[i] = (unsigned)(kk * 64 + lc * 8); }
        { const int t = 4 * q + (lane >> 4), l16 = (lane & 15) ^ (t & 15); qsrc[i] = (unsigned)(t * 512 + l16 * 8); } }
    unsigned vsrc; { const int vr = 8 * wave + (lane >> 3), lc = (lane & 7) ^ (vr & 7); vsrc = (unsigned)(vr * 64 + lc * 8); }
    const unsigned dsrc = (unsigned)((wave & 1) * 64 + lane);
#define GLA_ISSUE(cc, stg) do { const int _c = (cc); LAS unsigned char* _sb = lds + (stg) * GSTG; \
        const bf16_t* _kp = KTb + (size_t)_c * 8192; const bf16_t* _qp = Qb + (size_t)_c * 32768; const bf16_t* _vp = VTb + (size_t)_c * 16384; \
        _Pragma("unroll") for (int _i = 0; _i < 2; ++_i) __builtin_amdgcn_global_load_lds((const unsigned*)(_kp + ksrc[_i]), (LAS unsigned*)(_sb + G_KB + 1024 * (2 * wave + _i)), 16, 0, 0); \
        _Pragma("unroll") for (int _i = 0; _i < 2; ++_i) __builtin_amdgcn_global_load_lds((const unsigned*)(_qp + qsrc[_i]), (LAS unsigned*)(_sb + G_QB + 1024 * (2 * wave + _i)), 16, 0, 0); \
        __builtin_amdgcn_global_load_lds((const unsigned*)(_vp + vsrc), (LAS unsigned*)(_sb + G_VB + 1024 * wave), 16, 0, 0); \
        __builtin_amdgcn_global_load_lds((const unsigned*)(DCb + (size_t)_c * 512 + dsrc), (LAS unsigned*)(_sb + G_DB + (wave & 1) * 256), 4, 0, 0); } while (0)
    const int kx = li & 7;
    unsigned ka[2], va[2], qa[4], qb[4];
#pragma unroll
    for (int st = 0; st < 2; ++st) { ka[st] = (unsigned)(G_KB + li * 128 + (((4 * st + g) ^ kx) * 16)); va[st] = (unsigned)(G_VB + (16 * vg + li) * 128 + (((4 * st + g) ^ kx) * 16)); }
#pragma unroll
    for (int p = 0; p < 4; ++p) { const int ph = (4 * p + (g >> 1)) ^ li; qa[p] = (unsigned)(G_QB + li * 256 + ph * 16 + 8 * (g & 1)); qb[p] = (unsigned)(G_QB + li * 256 + (ph ^ 2) * 16 + 8 * (g & 1)); }
    const unsigned da = (unsigned)(G_DB + 16 * g);
    f32x4 S[8];
#pragma unroll
    for (int m = 0; m < 8; ++m) S[m] = (f32x4){0.f, 0.f, 0.f, 0.f};
    u32x2 oprev[2]; float sprev[2];
    oprev[0] = (u32x2){0u, 0u}; oprev[1] = (u32x2){0u, 0u}; sprev[0] = 0.f; sprev[1] = 0.f;
    u32x2 gA0, gA1, gB0, gB1;
    GLA_ISSUE(0, 0);
    { const bf16_t* gp0 = arow; const bf16_t* gp1 = gp0 + (size_t)16 * 2048;
      asm volatile("global_load_dwordx2 %0, %1, off" : "=v"(gA0) : "v"(gp0) : "memory");
      asm volatile("global_load_dwordx2 %0, %1, off" : "=v"(gA1) : "v"(gp1) : "memory"); }
    GLA_ISSUE(1, 1);
#define GLA_CHUNK(c, CUR0, CUR1, NXT0, NXT1) do { \
        asm volatile("s_waitcnt vmcnt(8)" ::: "memory");              \
        __builtin_amdgcn_s_barrier();                                 \
        asm volatile("" ::: "memory"); \
        if ((c) > 0) {                                                \
            _Pragma("unroll") for (int j = 0; j < 2; ++j) { bf16_t* ap = arow + (size_t)(((c) - 1) * 64 + 16 * j) * 2048; *(u32x2*)ap = oprev[j]; \
                if (g == 0) OSS[(((size_t)b * SEQ + ((c) - 1) * 64 + 32 * th + 16 * j + li) * 4 + h) * 16 + j16] = sprev[j]; } } \
        { const int cg = (c) + 1 < 64 ? (c) + 1 : 63; const bf16_t* gp0 = arow + (size_t)(cg * 64) * 2048; const bf16_t* gp1 = gp0 + (size_t)16 * 2048;     \
          asm volatile("global_load_dwordx2 %0, %1, off" : "=v"(NXT0) : "v"(gp0) : "memory"); \
          asm volatile("global_load_dwordx2 %0, %1, off" : "=v"(NXT1) : "v"(gp1) : "memory"); } \
        { const int cn = (c) + 2 < 64 ? (c) + 2 : 63; const int sn = ((c) + 2) % 3; GLA_ISSUE(cn, sn); } \
        LAS unsigned char* sbp = lds + ((c) % 3) * GSTG; \
        const bf16x8 vf0 = *(const LAS bf16x8*)(sbp + va[0]), vf1 = *(const LAS bf16x8*)(sbp + va[1]); \
        _Pragma("unroll") for (int m = 0; m < 8; ++m) { const f32x4 dc = *(const LAS f32x4*)(sbp + da + m * 64); S[m] = S[m] * dc; \
            S[m] = mfma16(*(const LAS bf16x8*)(sbp + ka[0] + m * 2048), vf0, S[m]); S[m] = mfma16(*(const LAS bf16x8*)(sbp + ka[1] + m * 2048), vf1, S[m]); } \
        bf16x8 sb[4]; \
        _Pragma("unroll") for (int p = 0; p < 4; ++p) { u32x4 w; w.x = cvt_pk_bf16_c(S[2 * p][0], S[2 * p][1]); w.y = cvt_pk_bf16_c(S[2 * p][2], S[2 * p][3]); \
            w.z = cvt_pk_bf16_c(S[2 * p + 1][0], S[2 * p + 1][1]); w.w = cvt_pk_bf16_c(S[2 * p + 1][2], S[2 * p + 1][3]); sb[p] = as_bf16x8(w); } \
        f32x4 o[2]; \
        _Pragma("unroll") for (int j = 0; j < 2; ++j) { const int tt = 2 * th + j; \
            o[j] = (f32x4){0.f, 0.f, 0.f, 0.f}; \
            _Pragma("unroll") for (int p = 0; p < 4; ++p) o[j] = mfma16(sb[p], cat8(*(const LAS s16x4*)(sbp + qa[p] + tt * 4096), *(const LAS s16x4*)(sbp + qb[p] + tt * 4096)), o[j]); } \
        asm volatile("s_waitcnt vmcnt(14)" : "+v"(CUR0), "+v"(CUR1) :: "memory");       \
        __builtin_amdgcn_sched_barrier(0); \
        _Pragma("unroll") for (int j = 0; j < 2; ++j) { const u32x2 gw = j ? CUR1 : CUR0; \
            float ss = (o[j][0] * o[j][0] + o[j][1] * o[j][1]) + (o[j][2] * o[j][2] + o[j][3] * o[j][3]); \
            ss += __shfl_xor(ss, 16); ss += __shfl_xor(ss, 32); \
            sprev[j] = ss; \
            oprev[j].x = cvt_pk_bf16(o[j][0] * bflo(gw.x) * gn[0], o[j][1] * bfhi(gw.x) * gn[1]); oprev[j].y = cvt_pk_bf16(o[j][2] * bflo(gw.y) * gn[2], o[j][3] * bfhi(gw.y) * gn[3]); } \
    } while (0)
#pragma unroll 1
    for (int c = 0; c < 64; c += 2) { GLA_CHUNK(c, gA0, gA1, gB0, gB1); GLA_CHUNK(c + 1, gB0, gB1, gA0, gA1); }
#undef GLA_CHUNK
    asm volatile("s_waitcnt vmcnt(0)" ::: "memory");
    __builtin_amdgcn_s_barrier();
    asm volatile("" ::: "memory");
#pragma unroll
    for (int j = 0; j < 2; ++j) { bf16_t* ap = arow + (size_t)(63 * 64 + 16 * j) * 2048; *(u32x2*)ap = oprev[j];
        if (g == 0) OSS[(((size_t)b * SEQ + 63 * 64 + 32 * th + 16 * j + li) * 4 + h) * 16 + j16] = sprev[j]; }
#undef GLA_ISSUE
}
__device__ __forceinline__ void xattn_unit(const Ptrs& P, int b, int h, int t0, int lane) {
    unsigned char* ws = P.ws;
    const bf16_t* XQ = (const bf16_t*)(ws + WS_XQ); bf16_t* A2 = (bf16_t*)(ws + WS_A2);
    const bf16_t* kmb = (const bf16_t*)(ws + WS_KM) + (size_t)(b * 4 + h) * 256 * 128; const bf16_t* vmb = (const bf16_t*)(ws + WS_VMT) + (size_t)(b * 4 + h) * 128 * 256;
    const int li = lane & 31, hh = lane >> 5;
    bf16x8 qf[8];
#pragma unroll
    for (int st = 0; st < 8; ++st) qf[st] = ld16(XQ + (size_t)(t0 + li) * 512 + h * 128 + 16 * st + 8 * hh);
    f32x16 X[8];
#pragma unroll
    for (int kt = 0; kt < 8; ++kt) {
#pragma unroll
        for (int i = 0; i < 16; ++i) X[kt][i] = 0.f;
#pragma unroll
        for (int st = 0; st < 8; ++st) X[kt] = mfma32(ld16(kmb + (size_t)(32 * kt + li) * 128 + 16 * st + 8 * hh), qf[st], X[kt]);
    }
    float mx = -3.0e38f;
#pragma unroll
    for (int kt = 0; kt < 8; ++kt)
#pragma unroll
        for (int i = 0; i < 16; ++i) mx = fmaxf(mx, X[kt][i]);
    mx = fmaxf(mx, __shfl_xor(mx, 32));
    float sum = 0.f;
#pragma unroll
    for (int kt = 0; kt < 8; ++kt)
#pragma unroll
        for (int i = 0; i < 16; ++i) { const float e = ex2(X[kt][i] - mx); X[kt][i] = e; sum += e; }
    sum += __shfl_xor(sum, 32);
    const float inv = 1.f / sum;
    bf16x8 pf[8][2];
#pragma unroll
    for (int kt = 0; kt < 8; ++kt)
#pragma unroll
        for (int s2 = 0; s2 < 2; ++s2) {
            u32x4 w; w.x = cvt_pk_bf16_c(X[kt][8 * s2 + 0], X[kt][8 * s2 + 1]); w.y = cvt_pk_bf16_c(X[kt][8 * s2 + 2], X[kt][8 * s2 + 3]);
            w.z = cvt_pk_bf16_c(X[kt][8 * s2 + 4], X[kt][8 * s2 + 5]); w.w = cvt_pk_bf16_c(X[kt][8 * s2 + 6], X[kt][8 * s2 + 7]);
            pf[kt][s2] = as_bf16x8(w); }
    bf16_t* orow = A2 + (size_t)(t0 + li) * 2048 + 1536 + h * 128 + 4 * hh;
#pragma unroll
    for (int nt = 0; nt < 4; ++nt) {
        f32x16 O;
#pragma unroll
        for (int i = 0; i < 16; ++i) O[i] = 0.f;
        const bf16_t* vr = vmb + (size_t)(32 * nt + li) * 256 + 4 * hh;
#pragma unroll
        for (int kt = 0; kt < 8; ++kt)
#pragma unroll
            for (int s2 = 0; s2 < 2; ++s2) O = mfma32(cat8(*(const s16x4*)(vr + 32 * kt + 16 * s2), *(const s16x4*)(vr + 32 * kt + 16 * s2 + 8)), pf[kt][s2], O);
#pragma unroll
        for (int rr = 0; rr < 4; ++rr) { u32x2 w; w.x = cvt_pk_bf16(O[4 * rr] * inv, O[4 * rr + 1] * inv); w.y = cvt_pk_bf16(O[4 * rr + 2] * inv, O[4 * rr + 3] * inv);
            *(u32x2*)(orow + 32 * nt + 8 * rr) = w; }
        asm volatile("" ::: "memory");
    }
}
__device__ __forceinline__ void xattn_unit_lds(const Ptrs& P, LAS unsigned char* lds, int h, int t0, int lane) {
    unsigned char* ws = P.ws;
    const bf16_t* XQ = (const bf16_t*)(ws + WS_XQ); bf16_t* A2 = (bf16_t*)(ws + WS_A2);
    const int li = lane & 31, hh = lane >> 5;
    bf16x8 qf[8];
#pragma unroll
    for (int st = 0; st < 8; ++st) qf[st] = ld16(XQ + (size_t)(t0 + li) * 512 + h * 128 + 16 * st + 8 * hh);
    f32x16 X[8];
    const unsigned kb = (unsigned)(li * 256), kx = (unsigned)(li & 15);
#pragma unroll
    for (int kt = 0; kt < 8; ++kt) {
#pragma unroll
        for (int i = 0; i < 16; ++i) X[kt][i] = 0.f;
#pragma unroll
        for (int st = 0; st < 8; ++st) X[kt] = mfma32(*(const LAS bf16x8*)(lds + kt * 8192 + kb + (((unsigned)(2 * st + hh) ^ kx) * 16)), qf[st], X[kt]);
    }
    float mx = -3.0e38f;
#pragma unroll
    for (int kt = 0; kt < 8; ++kt)
#pragma unroll
        for (int i = 0; i < 16; ++i) mx = fmaxf(mx, X[kt][i]);
    mx = fmaxf(mx, __shfl_xor(mx, 32));
    float sum = 0.f;
#pragma unroll
    for (int kt = 0; kt < 8; ++kt)
#pragma unroll
        for (int i = 0; i < 16; ++i) { const float e = ex2(X[kt][i] - mx); X[kt][i] = e; sum += e; }
    sum += __shfl_xor(sum, 32);
    const float inv = 1.f / sum;
    bf16x8 pf[8][2];
#pragma unroll
    for (int kt = 0; kt < 8; ++kt)
#pragma unroll
        for (int s2 = 0; s2 < 2; ++s2) {
            u32x4 w; w.x = cvt_pk_bf16_c(X[kt][8 * s2 + 0], X[kt][8 * s2 + 1]); w.y = cvt_pk_bf16_c(X[kt][8 * s2 + 2], X[kt][8 * s2 + 3]);
            w.z = cvt_pk_bf16_c(X[kt][8 * s2 + 4], X[kt][8 * s2 + 5]); w.w = cvt_pk_bf16_c(X[kt][8 * s2 + 6], X[kt][8 * s2 + 7]);
            pf[kt][s2] = as_bf16x8(w); }
    bf16_t* orow = A2 + (size_t)(t0 + li) * 2048 + 1536 + h * 128 + 4 * hh;
    const unsigned vx = (unsigned)li;
#pragma unroll
    for (int nt = 0; nt < 4; ++nt) {
        f32x16 O;
#pragma unroll
        for (int i = 0; i < 16; ++i) O[i] = 0.f;
        const unsigned vb = 65536u + (unsigned)((32 * nt + li) * 512) + 8u * (unsigned)hh;
#pragma unroll
        for (int kt = 0; kt < 8; ++kt)
#pragma unroll
            for (int s2 = 0; s2 < 2; ++s2) { const unsigned c0 = (unsigned)(4 * kt + 2 * s2);
                O = mfma32(cat8(*(const LAS s16x4*)(lds + vb + ((c0 ^ vx) * 16)), *(const LAS s16x4*)(lds + vb + (((c0 + 1) ^ vx) * 16))), pf[kt][s2], O); }
#pragma unroll
        for (int rr = 0; rr < 4; ++rr) { u32x2 w; w.x = cvt_pk_bf16(O[4 * rr] * inv, O[4 * rr + 1] * inv); w.y = cvt_pk_bf16(O[4 * rr + 2] * inv, O[4 * rr + 3] * inv);
            *(u32x2*)(orow + 32 * nt + 8 * rr) = w; }
        asm volatile("" ::: "memory");
    }
}
__device__ __forceinline__ void xattn_task(const Ptrs& P, LAS unsigned char* lds, int bh, int qtr, int wave, int lane) {
    unsigned char* ws = P.ws;
    const bf16_t* kmb = (const bf16_t*)(ws + WS_KM) + (size_t)bh * 256 * 128; const bf16_t* vmb = (const bf16_t*)(ws + WS_VMT) + (size_t)bh * 128 * 256;
    asm volatile("" : "+v"(lane));
#pragma unroll
    for (int i = 0; i < 8; ++i) { const int q = 8 * wave + i;
        const int row = 4 * q + (lane >> 4), lc = (lane & 15) ^ (row & 15);
        __builtin_amdgcn_global_load_lds((const unsigned*)(kmb + (size_t)row * 128 + lc * 8), (LAS unsigned*)(lds + 1024 * q), 16, 0, 0); }
#pragma unroll
    for (int i = 0; i < 8; ++i) { const int q = 8 * wave + i;
        const int row = 2 * q + (lane >> 5), lc = (lane & 31) ^ (row & 31);
        __builtin_amdgcn_global_load_lds((const unsigned*)(vmb + (size_t)row * 256 + lc * 8), (LAS unsigned*)(lds + 65536 + 1024 * q), 16, 0, 0); }
    asm volatile("s_waitcnt vmcnt(0)" ::: "memory");
    __syncthreads();
    const int b = bh >> 2, h = bh & 3;
#pragma unroll 1
    for (int it = 0; it < 4; ++it) { xattn_unit_lds(P, lds, h, b * SEQ + qtr * 1024 + it * 256 + wave * 32, lane); asm volatile("" ::: "memory"); }
    __syncthreads();
}
constexpr int POOL_PITCH = 272, POOL_WSCR = 48 * POOL_PITCH;
template <int G> __device__ __forceinline__ void pool_unit_g(const Ptrs& P, LAS unsigned char* sc, int t0, int lane) {
    constexpr int W = 2 << G, NR = W + 31, NP = NR * 16, NL = (NP + 63) / 64;
    unsigned char* ws = P.ws;
    const bf16_t* PIN = (const bf16_t*)(ws + WS_PIN); const bf16_t* WP = (const bf16_t*)(ws + WS_WPOOL) + G * 16384; bf16_t* A2 = (bf16_t*)(ws + WS_A2);
    const float* pscale = P.in[I_PSCALE] + G * 128;
    const int li = lane & 31, hh = lane >> 5, t = t0 + li, pos = t & (SEQ - 1), cnt = (pos + 1 < W) ? pos + 1 : W;
    const float icnt = 1.f / (float)cnt;
    { const int seq0 = t0 & ~(SEQ - 1);
      u32x4 v[NL];
#pragma unroll
      for (int i = 0; i < NL; ++i) { const int q = lane + 64 * i, j = q >> 4, c = q & 15; int r = t0 - (W - 1) + j; r = r < seq0 ? seq0 : r;
          if (q < NP) v[i] = *(const u32x4*)(PIN + (size_t)r * 512 + G * 128 + 8 * c); }
#pragma unroll
      for (int i = 0; i < NL; ++i) { const int q = lane + 64 * i, j = q >> 4, c = q & 15;
          if (q < NP) *(LAS u32x4*)(sc + j * POOL_PITCH + c * 16) = v[i]; }
      asm volatile("s_waitcnt lgkmcnt(0)" ::: "memory"); }
    f32x16 Dd[4];
#pragma unroll
    for (int nt = 0; nt < 4; ++nt)
#pragma unroll
        for (int i = 0; i < 16; ++i) Dd[nt][i] = 0.f;
    const LAS unsigned char* rowp = sc + (li + W - 1) * POOL_PITCH + 16 * hh;
#pragma unroll
    for (int st = 0; st < 8; ++st) {
        bf16x8 wq[4];
#pragma unroll
        for (int nt = 0; nt < 4; ++nt) wq[nt] = ld16(WP + (size_t)(32 * nt + li) * 128 + 16 * st + 8 * hh);
        float a[8] = {0.f, 0.f, 0.f, 0.f, 0.f, 0.f, 0.f, 0.f};
        const u32x4 own = *(const LAS u32x4*)(rowp + 32 * st);
#pragma unroll
        for (int i = 0; i < W; ++i) { const u32x4 x = *(const LAS u32x4*)(rowp + 32 * st - (i < cnt ? i : 0) * POOL_PITCH); const float wgt = (i < cnt) ? 1.f : 0.f;
            a[0] += wgt * bflo(x.x); a[1] += wgt * bfhi(x.x); a[2] += wgt * bflo(x.y); a[3] += wgt * bfhi(x.y);
            a[4] += wgt * bflo(x.z); a[5] += wgt * bfhi(x.z); a[6] += wgt * bflo(x.w); a[7] += wgt * bfhi(x.w); }
        u32x4 mw;
        mw.x = cvt_pk_bf16(a[0] * icnt - bflo(own.x), a[1] * icnt - bfhi(own.x)); mw.y = cvt_pk_bf16(a[2] * icnt - bflo(own.y), a[3] * icnt - bfhi(own.y));
        mw.z = cvt_pk_bf16(a[4] * icnt - bflo(own.z), a[5] * icnt - bfhi(own.z)); mw.w = cvt_pk_bf16(a[6] * icnt - bflo(own.w), a[7] * icnt - bfhi(own.w));
        asm volatile("s_nop 3" : "+v"(mw));
        const bf16x8 mf = as_bf16x8(mw);
#pragma unroll
        for (int nt = 0; nt < 4; ++nt) Dd[nt] = mfma32(wq[nt], mf, Dd[nt]);
    }
    asm volatile("s_waitcnt lgkmcnt(0)" ::: "memory");
    bf16_t* orow = A2 + (size_t)t * 2048 + 1024 + G * 128 + 4 * hh;
#pragma unroll
    for (int nt = 0; nt < 4; ++nt)
#pragma unroll
        for (int rr = 0; rr < 4; ++rr) { const f32x4 scv = *(const f32x4*)(pscale + 32 * nt + 8 * rr + 4 * hh);
            u32x2 o; o.x = cvt_pk_bf16(Dd[nt][4 * rr] * scv[0], Dd[nt][4 * rr + 1] * scv[1]); o.y = cvt_pk_bf16(Dd[nt][4 * rr + 2] * scv[2], Dd[nt][4 * rr + 3] * scv[3]);
            *(u32x2*)(orow + 32 * nt + 8 * rr) = o; }
}
__device__ __forceinline__ void gla_rfac_rows(const Ptrs& P) {
    const float* OSS = (const float*)(P.ws + WS_OSS); f32x4* RR = (f32x4*)(P.ws + WS_DEC);
    if (threadIdx.x < 128) for (int row = blockIdx.x * 128 + threadIdx.x; row < T; row += gridDim.x * 128) {
        float r[4];
#pragma unroll
        for (int h = 0; h < 4; ++h) { const float* op = OSS + ((size_t)row * 4 + h) * 16;
            const f32x4 s0 = *(const f32x4*)op, s1 = *(const f32x4*)(op + 4), s2 = *(const f32x4*)(op + 8), s3 = *(const f32x4*)(op + 12);
            const f32x4 s = (s0 + s1) + (s2 + s3);
            r[h] = rsqrtf(((s[0] + s[1]) + (s[2] + s[3])) * (1.f / 256.f) + EPS); }
        RR[row] = (f32x4){r[0] / r[1], r[1] / r[2], r[2] / r[3], r[3]};
    }
}

constexpr int CW_QUEUE = 12288;
__device__ __forceinline__ void p5_mixers(const Ptrs& P, LAS unsigned char* lds, int wave, int lane) {
    int gidx;
    if (gridDim.x == 256) { const int bx = (int)blockIdx.x;
        gidx = ((bx >> 3) & 1) == 0 ? (((bx & 7) * 4 + ((bx >> 4) >> 2)) * 4 + ((bx >> 4) & 3)) : -1; }
    else gidx = (int)blockIdx.x < 128 ? (int)blockIdx.x : -1;
    if (gidx >= 0) gla_block(P, lds, gidx >> 2, gidx & 3, wave, lane);
    unsigned* qh = (unsigned*)(P.ws + WS_CTL) + CW_QUEUE;
    for (;;) {
        if (threadIdx.x == 0) *(LAS unsigned*)(lds + LDSCTL_OFF + 512) = __hip_atomic_fetch_add(qh, 1u, __ATOMIC_RELAXED, __HIP_MEMORY_SCOPE_AGENT);
        __syncthreads();
        const unsigned it = *(const LAS unsigned*)(lds + LDSCTL_OFF + 512);
        __syncthreads();
        if (it >= 128u) break;
        xattn_task(P, lds, (int)it >> 2, (int)it & 3, wave, lane);
    }
    asm volatile("" ::: "memory");
#define POOL_LOOP(G) for (;;) { unsigned it = 0; if (lane == 0) it = __hip_atomic_fetch_add(qh + 64 * (1 + G), 1u, __ATOMIC_RELAXED, __HIP_MEMORY_SCOPE_AGENT); \
        it = (unsigned)__builtin_amdgcn_readfirstlane((int)it); if (it >= 1024u) break; pool_unit_g<G>(P, lds + wave * POOL_WSCR, (int)it * 32, lane); } asm volatile("" ::: "memory")
    POOL_LOOP(3); POOL_LOOP(2); POOL_LOOP(1); POOL_LOOP(0);
#undef POOL_LOOP
}
#define XB_TMO      128
#define XB_XCNT(j)  (256  + 64 * (j))
#define XB_XSUB(j)  (1280 + 64 * (j))
#define XB_XGEN(j)  (2304 + 64 * (j))
#define XB_TOP      3328
#define XB_TOPGEN   3392
#define XCD_BAR_WORDS 3456
#define XB_SPIN_CAP (1u << 18)

__device__ __forceinline__ unsigned xb_ld(unsigned* p)              { return __hip_atomic_load(p, __ATOMIC_RELAXED, __HIP_MEMORY_SCOPE_AGENT); }
__device__ __forceinline__ unsigned xb_add(unsigned* p, unsigned v) { return __hip_atomic_fetch_add(p, v, __ATOMIC_RELAXED, __HIP_MEMORY_SCOPE_AGENT); }
__device__ __forceinline__ unsigned xb_xcc_id() { return (unsigned)__builtin_amdgcn_s_getreg((3 << 11) | 20) & 0xFu; }
#define XB_SPIN(cond, bar) do { unsigned _sp = 0; while (cond) { __builtin_amdgcn_s_sleep(1); \
    if ((++_sp & 255u) == 0u) { if (xb_ld(&(bar)[XB_TMO])) break; if (_sp > XB_SPIN_CAP) { atomicAdd(&(bar)[XB_TMO], 1u); break; } } } } while (0)

struct XcdBarrier {
    unsigned* bar; unsigned x;
    volatile LAS unsigned* st;
};

__device__ __forceinline__ XcdBarrier xcd_barrier_post(unsigned* bar, volatile LAS unsigned* st) {
    XcdBarrier b; b.bar = bar; b.x = xb_xcc_id(); b.st = st;
    if (threadIdx.x == 0) (void)xb_add(&bar[XB_XCNT(b.x)], 1u);
    return b;
}
__device__ __forceinline__ void xcd_barrier_complete(unsigned* bar, unsigned x, unsigned& nloc, unsigned& nx) {
    const unsigned G = gridDim.x * gridDim.y * gridDim.z;
    unsigned sum, cnt, mine, sp = 0u;
    for (;;) {
        sum = 0u; cnt = 0u; mine = 0u;
#pragma unroll
        for (unsigned j = 0; j < 16; ++j) { const unsigned c = xb_ld(&bar[XB_XCNT(j)]); sum += c; cnt += (c > 0u) ? 1u : 0u; mine = (j == x) ? c : mine; }
        if (sum == G) break;
        __builtin_amdgcn_s_sleep(1);
        if ((++sp & 255u) == 0u) { if (xb_ld(&bar[XB_TMO])) break; if (sp > XB_SPIN_CAP) { atomicAdd(&bar[XB_TMO], 1u); break; } }
    }
    nloc = mine > 0u ? mine : 1u; nx = cnt > 0u ? cnt : 1u;
}

__device__ __forceinline__ void xcd_barrier(const XcdBarrier& b) {
    asm volatile("s_waitcnt vmcnt(0)" ::: "memory");
    __syncthreads();
    if (threadIdx.x == 0) {
        unsigned* bar = b.bar;
        __builtin_amdgcn_s_waitcnt(0);
        unsigned nloc = b.st[0], nx = b.st[1];
        if (nloc == 0u) { xcd_barrier_complete(bar, b.x, nloc, nx); b.st[0] = nloc; b.st[1] = nx; }
        const unsigned old = xb_add(&bar[XB_XSUB(b.x)], 1u);
        const unsigned gen = old / nloc;
        if (old + 1u == (gen + 1u) * nloc) {
            __builtin_amdgcn_fence(__ATOMIC_RELEASE, "agent");
            asm volatile("s_waitcnt vmcnt(0)" ::: "memory");
            const unsigned og = xb_add(&bar[XB_TOP], 1u);
            const unsigned tg = og / nx;
            if (og + 1u == (tg + 1u) * nx) xb_add(&bar[XB_TOPGEN], 1u);
            else XB_SPIN(xb_ld(&bar[XB_TOPGEN]) == tg, bar);
            __builtin_amdgcn_fence(__ATOMIC_ACQUIRE, "agent");
            xb_add(&bar[XB_XGEN(b.x)], 1u);
            asm volatile("s_waitcnt vmcnt(0)" ::: "memory");
        } else {
            XB_SPIN(xb_ld(&bar[XB_XGEN(b.x)]) == gen, bar);
            __builtin_amdgcn_fence(__ATOMIC_ACQUIRE, "agent");
            asm volatile("s_waitcnt vmcnt(0)" ::: "memory");
        }
    }
    __syncthreads();
}

constexpr int NPHASE = 14;
#ifndef DBL
#define DBL -1
#endif
constexpr int DBL_PHASE = DBL;
__global__ void __launch_bounds__(NTHREADS, 2) fwd(Ptrs P) {
    extern __shared__ __attribute__((aligned(16))) unsigned char lds_raw[];
    LAS unsigned char* lds = (LAS unsigned char*)lds_raw;
    const int tid = threadIdx.x, lane = tid & 63, wave = __builtin_amdgcn_readfirstlane(tid >> 6);
    unsigned char* ws = P.ws;
    cooperative_groups::grid_group grid = cooperative_groups::this_grid();
    const int lo = P.ph_lo, hi = P.ph_hi;
    volatile LAS unsigned* MISC = (volatile LAS unsigned*)(lds + LDSCTL_OFF);
    if (tid < 64) MISC[tid] = 0u;
    __syncthreads();
    XcdBarrier bar = xcd_barrier_post((unsigned*)(ws + WS_CTL) + CW_BAR, MISC + 8);
#define IN(k) (lo <= (k) && (k) < hi)
#define SEAM(k) do { if (IN(k) && IN((k) + 1)) xcd_barrier(bar); } while (0)
    if (lo > hi) grid.sync();
    const int G = gridDim.x, c = blockIdx.x;
    bf16_t* HN = (bf16_t*)(ws + WS_HN); bf16_t* Gb = (bf16_t*)(ws + WS_M); float* Y = (float*)(ws + WS_A2); bf16_t* A2 = (bf16_t*)(ws + WS_A2);
    if (IN(0)) p0_prologue(P, lds, wave, lane);
    if constexpr (DBL_PHASE == 0) { if (IN(0)) { xcd_barrier(bar); p0_prologue(P, lds, wave, lane); } }
    SEAM(0);
    if (IN(1)) { pg8::Gemm g{HN, (const bf16_t*)(ws + WS_W1A), T, 2 * FF, D}; pg8::StaticOrder S; S.init(T, 2 * FF, G, c); EpiSwiglu E{Gb};
        pg8::gemm_phase<EpiSwiglu, pg8::StaticOrder, true, true>(lds, g, S, E); }
    if constexpr (DBL_PHASE == 1) { if (IN(1)) { xcd_barrier(bar); { pg8::Gemm g{HN, (const bf16_t*)(ws + WS_W1A), T, 2 * FF, D}; pg8::StaticOrder S; S.init(T, 2 * FF, G, c); EpiSwiglu E{Gb};
        pg8::gemm_phase<EpiSwiglu, pg8::StaticOrder, true, true>(lds, g, S, E); } } }
    SEAM(1);
    if (IN(2)) { pg8::Gemm g{Gb, (const bf16_t*)(ws + WS_W1B), T, D, FF}; pg8::StaticOrder S; S.init(T, D, G, c); EpiYbf E{(bf16_t*)Y};
        pg8::gemm_phase<EpiYbf, pg8::StaticOrder, true, true>(lds, g, S, E); }
    if constexpr (DBL_PHASE == 2) { if (IN(2)) { xcd_barrier(bar); { pg8::Gemm g{Gb, (const bf16_t*)(ws + WS_W1B), T, D, FF}; pg8::StaticOrder S; S.init(T, D, G, c); EpiYbf E{(bf16_t*)Y};
        pg8::gemm_phase<EpiYbf, pg8::StaticOrder, true, true>(lds, g, S, E); } } }
    SEAM(2);
    if (IN(3)) { memkv_tile(P, lds, wave, lane); row_pass<1>(P, lds, wave, lane); }
    if constexpr (DBL_PHASE == 3) { if (IN(3)) { xcd_barrier(bar); { memkv_tile(P, lds, wave, lane); row_pass<1>(P, lds, wave, lane); } } }
    SEAM(3);
    if (IN(4)) { pg8::Gemm g{HN, (const bf16_t*)(ws + WS_WIN), T, 4096, D}; pg8::StaticOrder S; S.init(T, 4096, G, c);
        EpiInProj E{(bf16_t*)(ws + WS_Q), (bf16_t*)(ws + WS_KT), (bf16_t*)(ws + WS_VT), A2, (bf16_t*)(ws + WS_PIN), (bf16_t*)(ws + WS_XQ), (float*)(ws + WS_DEC),
                    (const bf16_t*)(ws + WS_FLOW), (const bf16_t*)(ws + WS_WFU), P.in[I_BF], lds + LDSCTL_OFF + 1024};
        pg8::gemm_phase<EpiInProj, pg8::StaticOrder, true, true>(lds, g, S, E); }
    if constexpr (DBL_PHASE == 4) { if (IN(4)) { xcd_barrier(bar); { pg8::Gemm g{HN, (const bf16_t*)(ws + WS_WIN), T, 4096, D}; pg8::StaticOrder S; S.init(T, 4096, G, c);
        EpiInProj E{(bf16_t*)(ws + WS_Q), (bf16_t*)(ws + WS_KT), (bf16_t*)(ws + WS_VT), A2, (bf16_t*)(ws + WS_PIN), (bf16_t*)(ws + WS_XQ), (float*)(ws + WS_DEC),
                    (const bf16_t*)(ws + WS_FLOW), (const bf16_t*)(ws + WS_WFU), P.in[I_BF], lds + LDSCTL_OFF + 1024};
        pg8::gemm_phase<EpiInProj, pg8::StaticOrder, true, true>(lds, g, S, E); } } }
    SEAM(4);
    if (IN(5)) p5_mixers(P, lds, wave, lane);
    SEAM(5);
    if (IN(7)) { { pg8::Gemm g{HN, (const bf16_t*)(ws + WS_WIN) + (size_t)4096 * 1024, T, 3072, D}; pg8::StaticOrder S; S.init(T, 3072, G, c); EpiGates E{(bf16_t*)(ws + WS_M)};
        pg8::gemm_phase<EpiGates, pg8::StaticOrder, true, true>(lds, g, S, E); }
        gla_rfac_rows(P); }
    SEAM(7);
    if (IN(8)) { pg8::Gemm g{A2, (const bf16_t*)(ws + WS_WUP), T, D, 2048}; pg8::StaticOrder S; S.init(T, D, G, c); EpiMerge E{(const bf16_t*)(ws + WS_M), HN, (const float*)(ws + WS_DEC)};
        pg8::gemm_phase<EpiMerge, pg8::StaticOrder, true, true>(lds, g, S, E); }
    if constexpr (DBL_PHASE == 8) { if (IN(8)) { xcd_barrier(bar); { pg8::Gemm g{A2, (const bf16_t*)(ws + WS_WUP), T, D, 2048}; pg8::StaticOrder S; S.init(T, D, G, c); EpiMerge E{(const bf16_t*)(ws + WS_M), HN, (const float*)(ws + WS_DEC)};
        pg8::gemm_phase<EpiMerge, pg8::StaticOrder, true, true>(lds, g, S, E); } } }
    SEAM(8);
    if (IN(9)) { pg8::Gemm g{HN, (const bf16_t*)(ws + WS_WO), T, D, D}; pg8::StaticOrder S; S.init(T, D, G, c); EpiYbf E{(bf16_t*)Y};
        pg8::gemm_phase<EpiYbf, pg8::StaticOrder, true, true>(lds, g, S, E); }
    if constexpr (DBL_PHASE == 9) { if (IN(9)) { xcd_barrier(bar); { pg8::Gemm g{HN, (const bf16_t*)(ws + WS_WO), T, D, D}; pg8::StaticOrder S; S.init(T, D, G, c); EpiYbf E{(bf16_t*)Y};
        pg8::gemm_phase<EpiYbf, pg8::StaticOrder, true, true>(lds, g, S, E); } } }
    SEAM(9);
    if (IN(10)) row_pass<2>(P, lds, wave, lane);
    SEAM(10);
    if (IN(11)) { pg8::Gemm g{HN, (const bf16_t*)(ws + WS_W2A), T, 2 * FF, D}; pg8::StaticOrder S; S.init(T, 2 * FF, G, c); EpiSwiglu E{Gb};
        pg8::gemm_phase<EpiSwiglu, pg8::StaticOrder, true, true>(lds, g, S, E); }
    if constexpr (DBL_PHASE == 11) { if (IN(11)) { xcd_barrier(bar); { pg8::Gemm g{HN, (const bf16_t*)(ws + WS_W2A), T, 2 * FF, D}; pg8::StaticOrder S; S.init(T, 2 * FF, G, c); EpiSwiglu E{Gb};
        pg8::gemm_phase<EpiSwiglu, pg8::StaticOrder, true, true>(lds, g, S, E); } } }
    SEAM(11);
    if (IN(12)) { pg8::Gemm g{Gb, (const bf16_t*)(ws + WS_W2B), T, D, FF}; pg8::StaticOrder S; S.init(T, D, G, c); EpiYbf E{(bf16_t*)Y};
        pg8::gemm_phase<EpiYbf, pg8::StaticOrder, true, true>(lds, g, S, E); }
    if constexpr (DBL_PHASE == 12) { if (IN(12)) { xcd_barrier(bar); { pg8::Gemm g{Gb, (const bf16_t*)(ws + WS_W2B), T, D, FF}; pg8::StaticOrder S; S.init(T, D, G, c); EpiYbf E{(bf16_t*)Y};
        pg8::gemm_phase<EpiYbf, pg8::StaticOrder, true, true>(lds, g, S, E); } } }
    SEAM(12);
    if (IN(13)) row_pass<3>(P, lds, wave, lane);
#undef IN
#undef SEAM
}
}
#ifndef MK_MODE
#define MK_MODE 0
#endif
#if MK_MODE == 1
namespace dbg {
using mk::bf16_t;
__device__ __forceinline__ float b2f(bf16_t u) { return __uint_as_float((unsigned)u << 16); }
template <class F> __global__ void cmp_k(F f, const float* ref, int ldr, int rows, int cols, float* slot) {
    float d = 0.f, s = 0.f;
    for (size_t i = (size_t)blockIdx.x * 256 + threadIdx.x; i < (size_t)rows * cols; i += (size_t)gridDim.x * 256) {
        const int r = (int)(i / cols), c = (int)(i % cols); const float a = f(r, c), b = ref[(size_t)r * ldr + c]; d += (a - b) * (a - b); s += b * b; }
    for (int o = 32; o > 0; o >>= 1) { d += __shfl_down(d, o); s += __shfl_down(s, o); }
    if ((threadIdx.x & 63) == 0) { atomicAdd(slot, d); atomicAdd(slot + 1, s); }
}
template <class F> inline void cmp(hipStream_t st, F f, const float* ref, int ldr, int rows, int cols, float* slots, int k) {
    hipLaunchKernelGGL(cmp_k<F>, dim3(256), dim3(256), 0, st, f, ref, ldr, rows, cols, slots + 2 * k);
}
__global__ void report(const float* slots, int n, float tol, float* out) {
    if (threadIdx.x == 0 && blockIdx.x == 0) for (int k = 0; k < n; ++k) { const float rv = slots[2 * k] / fmaxf(slots[2 * k + 1], 1e-30f); if (!(rv < tol)) { out[0] = 1000.f * (float)(k + 1); break; } }
}
__global__ void sigm_k(const float* proj, float* o, int R) { const size_t i = (size_t)blockIdx.x * 256 + threadIdx.x; if (i < (size_t)R * 3072) { const size_t t = i / 3072; const int c = (int)(i % 3072); o[i] = nv::sigm_f(proj[t * 7184 + nv::OGT + c]); } }
__global__ void silu_k(const float* proj, float* o, int R) { const size_t i = (size_t)blockIdx.x * 256 + threadIdx.x; if (i < (size_t)R * 1024) { const size_t t = i / 1024; const int c = (int)(i % 1024); o[i] = nv::silu_f(proj[t * 7184 + nv::OG + c]); } }
}
#endif

extern "C" void kernel_launch(void* const* d_in, const int* in_sizes, int n_in, void* d_out, int out_size, void* d_ws, size_t ws_size, hipStream_t stream) {
    static int grid = 0;
    if (grid == 0) {
        if (n_in != 25 || out_size != mk::T * 1024 || ws_size < mk::WS_END) { fprintf(stderr, "kernel_launch: unexpected shapes (n_in %d out %d ws %zu)\n", n_in, out_size, ws_size); grid = -1; return; }
        int dev = 0, cus = 0, per_cu = 0;
        hipGetDevice(&dev); hipDeviceGetAttribute(&cus, hipDeviceAttributeMultiprocessorCount, dev);
        if (hipFuncSetAttribute((const void*)mk::fwd, hipFuncAttributeMaxDynamicSharedMemorySize, mk::LDS_BYTES) != hipSuccess) { fprintf(stderr, "kernel_launch: hipFuncSetAttribute failed\n"); grid = -1; return; }
        hipOccupancyMaxActiveBlocksPerMultiprocessor(&per_cu, (const void*)mk::fwd, mk::NTHREADS, mk::LDS_BYTES);
        if (per_cu < 1) { fprintf(stderr, "kernel_launch: occupancy query says %d blocks/CU\n", per_cu); (void)hipGetLastError(); per_cu = 1; }
        grid = cus;
        if (grid != 256) fprintf(stderr, "kernel_launch: note: %d CUs\n", grid);
    }
    if (grid < 0) return;
    mk::Ptrs p{};
    for (int i = 0; i < 25; ++i) p.in[i] = (const float*)d_in[i];
    p.out = (float*)d_out; p.ws = (unsigned char*)d_ws;
#if MK_MODE == 0
    p.ph_lo = 0; p.ph_hi = mk::NPHASE;
    if (hipMemsetAsync((char*)d_ws + mk::WS_CTL, 0, mk::CTL_BYTES, stream) != hipSuccess) { fprintf(stderr, "kernel_launch: memset failed\n"); return; }
    void* args[] = {&p};
    hipError_t e = hipLaunchCooperativeKernel((const void*)mk::fwd, dim3(grid), dim3(mk::NTHREADS), args, mk::LDS_BYTES, stream);
    if (e != hipSuccess) fprintf(stderr, "kernel_launch: cooperative launch failed: %s\n", hipGetErrorString(e));
#else
    constexpr int BC = 5, R = 512; constexpr size_t row0 = (size_t)BC * 4096;
    unsigned char* ws = (unsigned char*)d_ws;
    hipMemsetAsync(ws + mk::WS_CTL, 0, mk::CTL_BYTES, stream);
    float* slots = (float*)(ws + mk::WS_CTL + 1024);
    nv::Bufs b; const size_t nf = nv::carve(b, (float*)(ws + mk::WS_END), R, 256);
    if (mk::WS_END + nf * 4 > ws_size) { fprintf(stderr, "debug: ws too small (%zu)\n", ws_size); return; }
    auto F = [&](int i) { return (const float*)d_in[i]; };
    auto PH = [&](int k) { p.ph_lo = k; p.ph_hi = k + 1; hipLaunchKernelGGL(mk::fwd, dim3(grid), dim3(mk::NTHREADS), mk::LDS_BYTES, stream, p); };
    using mk::bf16_t; using dbg::b2f;
    const float* x = F(0) + row0 * 1024; float* out = (float*)d_out;
    const bf16_t* HN = (const bf16_t*)(ws + mk::WS_HN); const bf16_t* Gb = (const bf16_t*)(ws + mk::WS_M); const float* Y = (const float*)(ws + mk::WS_A2);
    const bf16_t* A2 = (const bf16_t*)(ws + mk::WS_A2);
    int k = 0;
    PH(0);
    hipLaunchKernelGGL(nv::rmsnorm, dim3(R), dim3(256), 0, stream, x, 1024, F(2), b.h, 1024, 1024);
    dbg::cmp(stream, [=] __device__(int r, int c) { return b2f(HN[(row0 + r) * 1024 + c]); }, b.h, 1024, R, 1024, slots, k++);
    hipLaunchKernelGGL(nv::rmsnorm, dim3(256), dim3(256), 0, stream, F(1) + (size_t)BC * 256 * 1024, 1024, F(13), b.memn, 1024, 1024);
    { const bf16_t* MEMN = (const bf16_t*)(ws + mk::WS_MEMN);
      dbg::cmp(stream, [=] __device__(int r, int c) { return b2f(MEMN[((size_t)BC * 256 + r) * 1024 + c]); }, b.memn, 1024, 256, 1024, slots, k++); }
    PH(1);
    nv::gemm(stream, b.h, 1024, F(3), 5632, b.big, 5632, R, 5632, 1024);
    hipLaunchKernelGGL(nv::swiglu, dim3((R * 2816 + 255) / 256), dim3(256), 0, stream, b.big, b.gg, R, 2816);
    dbg::cmp(stream, [=] __device__(int r, int c) { return b2f(Gb[(row0 + r) * 2816 + c]); }, b.gg, 2816, R, 2816, slots, k++);
    PH(2);
    nv::gemm(stream, b.gg, 2816, F(4), 1024, b.y, 1024, R, 1024, 2816);
    dbg::cmp(stream, [=] __device__(int r, int c) { return Y[(row0 + r) * 1024 + c]; }, b.y, 1024, R, 1024, slots, k++);
    PH(3);
    hipLaunchKernelGGL(nv::resid_norm, dim3(R), dim3(256), 0, stream, x, b.y, F(5), 0.5f, b.xo);
    dbg::cmp(stream, [=] __device__(int r, int c) { return out[(row0 + r) * 1024 + c]; }, b.xo, 1024, R, 1024, slots, k++);
    hipLaunchKernelGGL(nv::rmsnorm, dim3(R), dim3(256), 0, stream, b.xo, 1024, F(6), b.h, 1024, 1024);
    dbg::cmp(stream, [=] __device__(int r, int c) { return b2f(HN[(row0 + r) * 1024 + c]); }, b.h, 1024, R, 1024, slots, k++);
    nv::gemm(stream, b.h, 1024, F(7), 7184, b.big, 7184, R, 7184, 1024);
    { const bf16_t* FLOW = (const bf16_t*)(ws + mk::WS_FLOW);
      dbg::cmp(stream, [=] __device__(int r, int c) { return b2f(FLOW[(row0 + r) * 16 + c]); }, b.big + nv::OF, 7184, R, 16, slots, k++); }
    nv::gemm(stream, b.memn, 1024, F(14), 1024, b.kv, 1024, 256, 1024, 1024);
    { const bf16_t* KM = (const bf16_t*)(ws + mk::WS_KM); const bf16_t* VMT = (const bf16_t*)(ws + mk::WS_VMT);
      dbg::cmp(stream, [=] __device__(int r, int c) { return b2f(KM[((size_t)(BC * 4 + (c >> 7)) * 256 + r) * 128 + (c & 127)]); }, b.kv, 1024, 256, 512, slots, k++);
      dbg::cmp(stream, [=] __device__(int r, int c) { return b2f(VMT[((size_t)(BC * 4 + (c >> 7)) * 128 + (c & 127)) * 256 + r]); }, b.kv + 512, 1024, 256, 512, slots, k++); }
    PH(4);
    hipLaunchKernelGGL(nv::gla_prep, dim3((R / 64 * 512 + 255) / 256), dim3(256), 0, stream, b.big, F(8), F(9), b.kt, b.dec, R);
    { const bf16_t* Q = (const bf16_t*)(ws + mk::WS_Q); const bf16_t* KT = (const bf16_t*)(ws + mk::WS_KT); const bf16_t* VT = (const bf16_t*)(ws + mk::WS_VT);
      const bf16_t* PIN = (const bf16_t*)(ws + mk::WS_PIN); const bf16_t* XQ = (const bf16_t*)(ws + mk::WS_XQ); const float* DEC = (const float*)(ws + mk::WS_DEC);
      dbg::cmp(stream, [=] __device__(int r, int c) { return b2f(Q[(row0 + r) * 512 + c]) * (1.f / mk::QSCALE); }, b.big + nv::OQ, 7184, R, 512, slots, k++);
      dbg::cmp(stream, [=] __device__(int r, int c) { return b2f(KT[((size_t)((BC * 4 + (c >> 7)) * 64 + (r >> 6)) * 128 + (c & 127)) * 64 + (r & 63)]); }, b.kt, 512, R, 512, slots, k++);
      dbg::cmp(stream, [=] __device__(int r, int c) { return DEC[((size_t)BC * 64 + r) * 512 + c]; }, b.dec, 512, R / 64, 512, slots, k++);
      dbg::cmp(stream, [=] __device__(int r, int c) { return b2f(VT[((size_t)((BC * 4 + (c >> 8)) * 64 + (r >> 6)) * 256 + (c & 255)) * 64 + (r & 63)]); }, b.big + nv::OV, 7184, R, 1024, slots, k++);
      hipLaunchKernelGGL(dbg::silu_k, dim3((R * 1024 + 255) / 256), dim3(256), 0, stream, b.big, b.o, R);
      dbg::cmp(stream, [=] __device__(int r, int c) { return b2f(A2[(row0 + r) * 2048 + c]); }, b.o, 1024, R, 1024, slots, k++);
      dbg::cmp(stream, [=] __device__(int r, int c) { return b2f(PIN[(row0 + r) * 512 + c]); }, b.big + nv::OP, 7184, R, 512, slots, k++);
      dbg::cmp(stream, [=] __device__(int r, int c) { return b2f(XQ[(row0 + r) * 512 + c]) * (1.f / mk::XSCALE); }, b.big + nv::OX, 7184, R, 512, slots, k++); }
    PH(5);
    hipLaunchKernelGGL(nv::gla_scan, dim3(32), dim3(256), 0, stream, b.big, b.kt, b.dec, b.o, R);
    hipLaunchKernelGGL(nv::gla_out, dim3(R), dim3(256), 0, stream, b.o, b.big, F(10), b.ga);
    hipLaunchKernelGGL(nv::pool_mix, dim3((R * 512 + 255) / 256), dim3(256), 0, stream, b.big, b.mixed, R);
    hipLaunchKernelGGL(nv::pool_lin, dim3((R * 512 + 255) / 256), dim3(256), 0, stream, b.mixed, F(11), F(12), b.py, R);
    hipLaunchKernelGGL(nv::xattn, dim3(R * 4), dim3(256), 0, stream, b.big, b.kv, b.xa);
    dbg::cmp(stream, [=] __device__(int r, int c) { return b2f(A2[(row0 + r) * 2048 + 1024 + c]); }, b.py, 512, R, 512, slots, k++);
    dbg::cmp(stream, [=] __device__(int r, int c) { return b2f(A2[(row0 + r) * 2048 + 1536 + c]); }, b.xa, 512, R, 512, slots, k++);
    PH(6);
    { const bf16_t* GT = (const bf16_t*)(ws + mk::WS_M);
      hipLaunchKernelGGL(dbg::sigm_k, dim3((R * 3072 + 255) / 256), dim3(256), 0, stream, b.big, b.ya, R);
      dbg::cmp(stream, [=] __device__(int r, int c) { return b2f(GT[(row0 + r) * 3072 + c]); }, b.ya, 3072, R, 3072, slots, k++);
      dbg::cmp(stream, [=] __device__(int r, int c) { return b2f(A2[(row0 + r) * 2048 + c]); }, b.ga, 1024, R, 1024, slots, k++); }
    PH(7);
    nv::gemm(stream, b.ga, 1024, F(15), 1024, b.ya, 1024, R, 1024, 1024);
    nv::gemm(stream, b.py, 512, F(16), 1024, b.yb, 1024, R, 1024, 512);
    nv::gemm(stream, b.xa, 512, F(17), 1024, b.yc, 1024, R, 1024, 512);
    hipLaunchKernelGGL(nv::merge, dim3((R * 1024 + 255) / 256), dim3(256), 0, stream, b.big, b.ya, b.yb, b.yc, b.mg, R);
    dbg::cmp(stream, [=] __device__(int r, int c) { return b2f(HN[(row0 + r) * 1024 + c]); }, b.mg, 1024, R, 1024, slots, k++);
    PH(8);
    nv::gemm(stream, b.mg, 1024, F(18), 1024, b.y, 1024, R, 1024, 1024);
    dbg::cmp(stream, [=] __device__(int r, int c) { return Y[(row0 + r) * 1024 + c]; }, b.y, 1024, R, 1024, slots, k++);
    PH(9);
    hipLaunchKernelGGL(nv::resid_norm, dim3(R), dim3(256), 0, stream, b.xo, b.y, F(19), 1.0f, b.xo);
    dbg::cmp(stream, [=] __device__(int r, int c) { return out[(row0 + r) * 1024 + c]; }, b.xo, 1024, R, 1024, slots, k++);
    hipLaunchKernelGGL(nv::rmsnorm, dim3(R), dim3(256), 0, stream, b.xo, 1024, F(20), b.h, 1024, 1024);
    dbg::cmp(stream, [=] __device__(int r, int c) { return b2f(HN[(row0 + r) * 1024 + c]); }, b.h, 1024, R, 1024, slots, k++);
    PH(10);
    nv::gemm(stream, b.h, 1024, F(21), 5632, b.big, 5632, R, 5632, 1024);
    hipLaunchKernelGGL(nv::swiglu, dim3((R * 2816 + 255) / 256), dim3(256), 0, stream, b.big, b.gg, R, 2816);
    dbg::cmp(stream, [=] __device__(int r, int c) { return b2f(Gb[(row0 + r) * 2816 + c]); }, b.gg, 2816, R, 2816, slots, k++);
    PH(11);
    nv::gemm(stream, b.gg, 2816, F(22), 1024, b.y, 1024, R, 1024, 2816);
    dbg::cmp(stream, [=] __device__(int r, int c) { return Y[(row0 + r) * 1024 + c]; }, b.y, 1024, R, 1024, slots, k++);
    PH(12);
    hipLaunchKernelGGL(dbg::report, dim3(1), dim3(64), 0, stream, slots, k, 2e-3f, out);
#endif
}
```

```cpp
#include <hip/hip_runtime.h>
#include <hip/hip_cooperative_groups.h>
#include <cstdio>
#include <cstdint>
#define MK_MODE 0
namespace pg8 {
#define PG8_LAS __attribute__((address_space(3)))
typedef unsigned short bf16_t;
typedef short bf16x8 __attribute__((ext_vector_type(8)));
typedef float f32x4 __attribute__((ext_vector_type(4)));
typedef unsigned u32x4 __attribute__((ext_vector_type(4)));
constexpr int BM = 256, BK = 64, HALF = 128, HTB = HALF * BK * 2  , STAGE_BYTES = 8 * HTB, NXCD = 8, WGM = 8;

__host__ __device__ __forceinline__ int lds_byte(int r, int c) { const int st = (r >> 4) * 2 + (c >> 5), rr = r & 15, cc = c & 31, ob = rr * 64 + cc * 2; return st * 1024 + (ob ^ (((ob >> 9) & 1) << 5)); }
__host__ __device__ __forceinline__ void stage_rc(int b, int& R, int& C) { const int st = b / 1024, sb = b % 1024, swz = sb ^ (((sb >> 9) & 1) << 5); R = (st >> 1) * 16 + swz / 64; C = (st & 1) * 32 + (swz % 64) / 2; }
__host__ __device__ __forceinline__ int perm32(int rho) { const int n = rho >> 4, i = rho & 15; return 8 * (i >> 2) + 4 * n + (i & 3); }

struct Unit { int pm, pn; };
struct Gemm { const bf16_t* A; const bf16_t* Bt; int M, N, K; };

struct StaticOrder {
    int nM, nN, nwg, G, c;
    __host__ __device__ void init(int M, int N, int G_, int c_) { nM = M / BM; nN = N / BM; nwg = nM * nN; G = G_; c = c_; }
    __host__ __device__ bool next(int i, Unit& u) const {
        const long L = (long)i * G + c; if (L >= nwg) return false;
        int wgid = (int)L; { const int q = nwg / NXCD, r = nwg % NXCD, xcd = wgid % NXCD, off = wgid / NXCD; wgid = (xcd < r ? xcd * (q + 1) : r * (q + 1) + (xcd - r) * q) + off; }
        const int nig = WGM * nN, gid = wgid / nig, fm = gid * WGM, gsz = (nM - fm) < WGM ? (nM - fm) : WGM;
        u.pm = fm + ((wgid % nig) % gsz); u.pn = (wgid % nig) / gsz; return true;
    }
    __device__ __forceinline__ void a_ready(const Unit&) const {}
    __device__ __forceinline__ void done(const Unit&) const {}
};


template <class Epi, class Sched, bool ALIGN_EPI = false, bool SP2 = false>
__device__ __forceinline__ void gemm_phase(PG8_LAS unsigned char* lds, const Gemm g, const Sched& S, const Epi& E) {
    const int tid = threadIdx.x, wid = __builtin_amdgcn_readfirstlane(tid >> 6), lane = tid & 63, wr = wid >> 2, wc = wid & 3, fr = lane & 15, fq = lane >> 4;
    const int K = g.K, nt = K / BK;
    unsigned voffA[2], voffB[2];
#pragma unroll
    for (int i = 0; i < 2; ++i) { int R, C; stage_rc(tid * 16 + i * 8192, R, C); const int Rb = Epi::PERM ? ((R & ~31) + perm32(R & 31)) : R;
        voffA[i] = (unsigned)(R * K + C) * 2u; voffB[i] = (unsigned)(Rb * K + C) * 2u; }
    const size_t kstep = (size_t)(BK * 2);
    const size_t hstep = (size_t)HALF * K * 2;
    const size_t tstep = 2 * hstep;
    const unsigned ldsw = (unsigned)wid * 1024u;
    const int aoff = lds_byte(wr * 64 + fr, fq * 8), boff = lds_byte(wc * 32 + fr, fq * 8);
#define PG8_SA(b, h) (((b) * 2 + (h)) * HTB)
#define PG8_SB(b, h) ((4 + (b) * 2 + (h)) * HTB)
#define PG8_STAGE(bufoff, gbase, voff) do { _Pragma("unroll") for (int _i = 0; _i < 2; ++_i) \
        __builtin_amdgcn_global_load_lds((const unsigned*)((const char*)(gbase) + (voff)[_i]), (PG8_LAS unsigned*)(lds + (bufoff) + ldsw + _i * 8192), 16, 0, 0); } while (0)
#define PG8_LDA(dst, b, h) do { _Pragma("unroll") for (int m = 0; m < 4; ++m) _Pragma("unroll") for (int k = 0; k < 2; ++k) dst[m][k] = *(const PG8_LAS bf16x8*)(lds + PG8_SA(b, h) + aoff + m * 2048 + k * 1024); } while (0)
#define PG8_LDB(dst, b, h) do { _Pragma("unroll") for (int n = 0; n < 2; ++n) _Pragma("unroll") for (int k = 0; k < 2; ++k) dst[n][k] = *(const PG8_LAS bf16x8*)(lds + PG8_SB(b, h) + boff + n * 2048 + k * 1024); } while (0)
#define PG8_MMA(ai, bj, At, Bt) do { __builtin_amdgcn_s_setprio(1); _Pragma("unroll") for (int m = 0; m < 4; ++m) _Pragma("unroll") for (int n = 0; n < 2; ++n) _Pragma("unroll") for (int k = 0; k < 2; ++k) \
        acc[ai][bj][m][n] = __builtin_amdgcn_mfma_f32_16x16x32_bf16(Bt[n][k], At[m][k], acc[ai][bj][m][n], 0, 0, 0); __builtin_amdgcn_s_setprio(0); } while (0)
#define PG8_WAIT_V(n) asm volatile("s_waitcnt vmcnt(" #n ")" ::: "memory")
#define PG8_WAIT_L(n) asm volatile("s_waitcnt lgkmcnt(" #n ")" ::: "memory")
#define PG8_BAR __builtin_amdgcn_s_barrier()
#define PG8_SCHED __builtin_amdgcn_sched_barrier(0)
    Unit cur, nxt; int ui = 0;
    if (!S.next(0, cur)) return;
    f32x4 acc[2][2][4][2];
#pragma unroll
    for (int a = 0; a < 2; ++a)
#pragma unroll
        for (int b = 0; b < 2; ++b)
#pragma unroll
            for (int m = 0; m < 4; ++m)
#pragma unroll
                for (int n = 0; n < 2; ++n) acc[a][b][m][n] = (f32x4){0.f, 0.f, 0.f, 0.f};
    bf16x8 At[4][2], B0[2][2], B1[2][2];
    const char* cA = (const char*)g.A + (size_t)cur.pm * tstep; const char* cB = (const char*)g.Bt + (size_t)cur.pn * tstep;
    S.a_ready(cur);
    if constexpr (SP2) {
        PG8_STAGE(PG8_SB(0, 0), cB, voffB); PG8_STAGE(PG8_SB(0, 1), cB + hstep, voffB); PG8_STAGE(PG8_SA(0, 0), cA, voffA); PG8_STAGE(PG8_SA(0, 1), cA + hstep, voffA);
        if (wr == 1) PG8_BAR;
        PG8_WAIT_V(2); PG8_BAR;
        PG8_STAGE(PG8_SB(1, 0), cB + kstep, voffB); PG8_STAGE(PG8_SA(1, 0), cA + kstep, voffA); PG8_STAGE(PG8_SB(1, 1), cB + hstep + kstep, voffB);
        PG8_WAIT_V(6); PG8_BAR;
    } else {
        PG8_STAGE(PG8_SB(0, 0), cB, voffB); PG8_STAGE(PG8_SA(0, 0), cA, voffA); PG8_STAGE(PG8_SB(0, 1), cB + hstep, voffB); PG8_STAGE(PG8_SA(0, 1), cA + hstep, voffA);
        if (wr == 1) PG8_BAR;
        PG8_WAIT_V(4); PG8_BAR;
        PG8_STAGE(PG8_SB(1, 0), cB + kstep, voffB); PG8_STAGE(PG8_SA(1, 0), cA + kstep, voffA); PG8_STAGE(PG8_SB(1, 1), cB + hstep + kstep, voffB);
        PG8_WAIT_V(6); PG8_BAR;
    }
    for (;;) {
        const bool has_next = S.next(ui + 1, nxt);
        const char* nA = has_next ? (const char*)g.A + (size_t)nxt.pm * tstep : cA; const char* nB = has_next ? (const char*)g.Bt + (size_t)nxt.pn * tstep : cB;
        for (int t = 0; t < nt; t += 2) {
            const bool last = (t == nt - 2);
            if constexpr (Epi::KHOOK) { if (Epi::is_hook(t)) E.khook(acc, cur, t, wr, wc, fr, fq); }
            const char* a1 = cA + (size_t)(t + 1) * kstep;
            const char* a2 = last ? nA : cA + (size_t)(t + 2) * kstep; const char* b2 = last ? nB : cB + (size_t)(t + 2) * kstep;
            const char* a3 = a2 + kstep; const char* b3 = b2 + kstep;
            if (last && has_next) S.a_ready(nxt);
            if constexpr (SP2) {
            PG8_LDB(B0, 0, 0); PG8_LDB(B1, 0, 1); PG8_SCHED; PG8_LDA(At, 0, 0); PG8_STAGE(PG8_SA(1, 1), a1 + hstep, voffA);
            PG8_WAIT_V(8); PG8_WAIT_L(0); PG8_BAR; PG8_MMA(0, 0, At, B0); PG8_MMA(0, 1, At, B1); PG8_BAR; PG8_SCHED;
            PG8_LDA(At, 0, 1); PG8_STAGE(PG8_SB(0, 0), b2, voffB); PG8_STAGE(PG8_SB(0, 1), b2 + hstep, voffB); PG8_STAGE(PG8_SA(0, 0), a2, voffA);
            PG8_WAIT_V(8); PG8_WAIT_L(0); PG8_BAR; PG8_MMA(1, 0, At, B0); PG8_MMA(1, 1, At, B1); PG8_BAR; PG8_SCHED;
            PG8_LDB(B0, 1, 0); PG8_LDB(B1, 1, 1); PG8_SCHED; PG8_LDA(At, 1, 0); PG8_STAGE(PG8_SA(0, 1), a2 + hstep, voffA);
            PG8_WAIT_V(8); PG8_WAIT_L(0); PG8_BAR; PG8_MMA(0, 0, At, B0); PG8_MMA(0, 1, At, B1); PG8_BAR; PG8_SCHED;
            PG8_LDA(At, 1, 1); PG8_STAGE(PG8_SB(1, 0), b3, voffB); PG8_STAGE(PG8_SB(1, 1), b3 + hstep, voffB); PG8_STAGE(PG8_SA(1, 0), a3, voffA);
            PG8_WAIT_V(8); PG8_WAIT_L(0); PG8_BAR; PG8_MMA(1, 0, At, B0); PG8_MMA(1, 1, At, B1); PG8_BAR; PG8_SCHED;
            } else {
            PG8_LDB(B0, 0, 0); PG8_SCHED; PG8_LDA(At, 0, 0); PG8_STAGE(PG8_SA(1, 1), a1 + hstep, voffA);
            PG8_WAIT_L(8); PG8_BAR; PG8_WAIT_L(0); PG8_MMA(0, 0, At, B0); PG8_BAR; PG8_SCHED;
            PG8_LDB(B1, 0, 1); PG8_STAGE(PG8_SB(0, 0), b2, voffB);
            PG8_BAR; PG8_WAIT_L(0); PG8_MMA(0, 1, At, B1); PG8_BAR;
            PG8_LDA(At, 0, 1); PG8_STAGE(PG8_SA(0, 0), a2, voffA);
            PG8_BAR; PG8_WAIT_L(0); PG8_MMA(1, 0, At, B0); PG8_BAR; PG8_SCHED;
            PG8_STAGE(PG8_SB(0, 1), b2 + hstep, voffB);
            PG8_WAIT_V(6); PG8_BAR; PG8_MMA(1, 1, At, B1); PG8_BAR;
            PG8_LDB(B0, 1, 0); PG8_SCHED; PG8_LDA(At, 1, 0); PG8_STAGE(PG8_SA(0, 1), a2 + hstep, voffA);
            PG8_WAIT_L(8); PG8_BAR; PG8_WAIT_L(0); PG8_MMA(0, 0, At, B0); PG8_BAR; PG8_SCHED;
            PG8_LDB(B1, 1, 1); PG8_STAGE(PG8_SB(1, 0), b3, voffB);
            PG8_BAR; PG8_WAIT_L(0); PG8_MMA(0, 1, At, B1); PG8_BAR;
            PG8_LDA(At, 1, 1); PG8_STAGE(PG8_SA(1, 0), a3, voffA);
            PG8_BAR; PG8_WAIT_L(0); PG8_MMA(1, 0, At, B0); PG8_BAR; PG8_SCHED;
            PG8_STAGE(PG8_SB(1, 1), b3 + hstep, voffB);
            PG8_WAIT_V(6); PG8_BAR; PG8_MMA(1, 1, At, B1); PG8_BAR;
            }
        }
        if constexpr (ALIGN_EPI) { if (wr == 0) PG8_BAR; }
        asm volatile("s_nop 7\n\ts_nop 7\n\ts_nop 7" ::: "memory");
        if constexpr (!Epi::AFTER_DRAIN) { E(acc, cur, wr, wc, fr, fq); S.done(cur); }
        if (!has_next) break;
#pragma unroll
        for (int a = 0; a < 2; ++a)
#pragma unroll
            for (int b = 0; b < 2; ++b)
#pragma unroll
                for (int m = 0; m < 4; ++m)
#pragma unroll
                    for (int n = 0; n < 2; ++n) acc[a][b][m][n] = (f32x4){0.f, 0.f, 0.f, 0.f};
        cur = nxt; cA = nA; cB = nB; ++ui;
        if constexpr (ALIGN_EPI) { if (wr == 1) PG8_BAR; }
    }
    PG8_WAIT_V(0);
    if constexpr (!ALIGN_EPI) { if (wr == 0) PG8_BAR; }
    PG8_BAR;
    if constexpr (Epi::AFTER_DRAIN) { E.fused(acc, cur, wr, wc, fr, fq, lds, wid, lane); S.done(cur); }
#undef PG8_SA
#undef PG8_SB
#undef PG8_STAGE
#undef PG8_LDA
#undef PG8_LDB
#undef PG8_MMA
#undef PG8_WAIT_V
#undef PG8_WAIT_L
#undef PG8_BAR
#undef PG8_SCHED
}
}
namespace mk {
#define LAS __attribute__((address_space(3)))
typedef unsigned short bf16_t;
typedef short bf16x8 __attribute__((ext_vector_type(8)));
typedef short s16x4 __attribute__((ext_vector_type(4)));
typedef float f32x4 __attribute__((ext_vector_type(4)));
typedef float f32x16 __attribute__((ext_vector_type(16)));
typedef unsigned u32x4 __attribute__((ext_vector_type(4)));
typedef unsigned u32x2 __attribute__((ext_vector_type(2)));
using pg8::Unit;

constexpr int T = 32768, D = 1024, FF = 2816, NB = 8, SEQ = 4096;
constexpr float EPS = 1e-6f, LOG2E = 1.4426950408889634f, LN2 = 0.6931471805599453f;
constexpr float QSCALE = 0.08838834764831845f, XSCALE = 0.08838834764831845f * 1.4426950408889634f;
constexpr size_t MiB = 1u << 20;
constexpr size_t WS_CTL = 0, CTL_BYTES = 65536;
constexpr size_t WS_FLOW = 1 * MiB;
constexpr size_t WS_DEC = 2 * MiB;
constexpr size_t WS_OSS = 3 * MiB;
constexpr size_t WS_MEMN = 11 * MiB;
constexpr size_t WS_KM = 15 * MiB;
constexpr size_t WS_VMT = 17 * MiB;
constexpr size_t WS_WFU = 19 * MiB;
constexpr size_t WS_WF = 19 * MiB + 65536;
constexpr size_t WS_W1A = 20 * MiB, WS_W1B = 31 * MiB + 512 * 1024, WS_W2A = 37 * MiB + 512 * 1024, WS_W2B = 48 * MiB + 512 * 1024;
constexpr size_t WS_WIN = 54 * MiB + 512 * 1024, WS_WUP = 69 * MiB, WS_WO = 73 * MiB, WS_WMKV = 75 * MiB, WS_WPOOL = 77 * MiB;
constexpr size_t WS_HN = 78 * MiB;
constexpr size_t WS_M = 142 * MiB;
constexpr size_t WS_Q = WS_M, WS_KT = WS_M + 32 * MiB, WS_VT = WS_M + 64 * MiB, WS_PIN = WS_M + 128 * MiB, WS_XQ = WS_M + 160 * MiB;
constexpr size_t WS_A2 = 334 * MiB;
constexpr size_t WS_END = 462 * MiB;
static_assert(WS_W1A + (size_t)5632 * 1024 * 2 <= WS_W1B && WS_W1B + (size_t)1024 * 2816 * 2 <= WS_W2A && WS_W2A + (size_t)5632 * 1024 * 2 <= WS_W2B &&
              WS_W2B + (size_t)1024 * 2816 * 2 <= WS_WIN && WS_WIN + (size_t)7168 * 1024 * 2 <= WS_WUP && WS_WUP + (size_t)1024 * 2048 * 2 <= WS_WO && WS_WPOOL + 131072 <= WS_HN, "ws map");

constexpr int LDS_BYTES = 163840;
constexpr int LDSCTL_OFF = 131072;
constexpr int CW_BAR = 4096;
constexpr int NTHREADS = 512;

__device__ __forceinline__ unsigned cvt_pk_bf16(float lo, float hi) { unsigned r; asm volatile("s_nop 0\n\tv_cvt_pk_bf16_f32 %0, %1, %2" : "=v"(r) : "v"(lo), "v"(hi)); return r; }
typedef __bf16 bf16x2_t __attribute__((ext_vector_type(2)));
typedef float f32x2_t __attribute__((ext_vector_type(2)));
__device__ __forceinline__ unsigned cvt_pk_bf16_c(float lo, float hi) { const f32x2_t v = {lo, hi}; return __builtin_bit_cast(unsigned, __builtin_convertvector(v, bf16x2_t)); }
__device__ __forceinline__ float bflo(unsigned w) { return __uint_as_float(w << 16); }
__device__ __forceinline__ float bfhi(unsigned w) { return __uint_as_float(w & 0xffff0000u); }
__device__ __forceinline__ float ex2(float x) { return __builtin_amdgcn_exp2f(x); }
__device__ __forceinline__ float rcp(float x) { return __builtin_amdgcn_rcpf(x); }
__device__ __forceinline__ float silu(float a) { return a * rcp(1.f + ex2(-a * LOG2E)); }
__device__ __forceinline__ float sigm(float a) { return rcp(1.f + ex2(-a * LOG2E)); }
__device__ __forceinline__ float add_xor16(float x) { const unsigned u = __float_as_uint(x); const auto r = __builtin_amdgcn_permlane16_swap(u, u, false, false); return __uint_as_float(r[0]) + __uint_as_float(r[1]); }
__device__ __forceinline__ float add_xor32(float x) { const unsigned u = __float_as_uint(x); const auto r = __builtin_amdgcn_permlane32_swap(u, u, false, false); return __uint_as_float(r[0]) + __uint_as_float(r[1]); }
__device__ __forceinline__ float wave_sum(float v) {
#pragma unroll
    for (int o = 1; o < 64; o <<= 1) v += __shfl_xor(v, o);
    return v;
}
__device__ __forceinline__ bf16x8 ld16(const bf16_t* p) { return *(const bf16x8*)p; }
__device__ __forceinline__ bf16x8 cat8(s16x4 a, s16x4 b) { return __builtin_shufflevector(a, b, 0, 1, 2, 3, 4, 5, 6, 7); }
__device__ __forceinline__ bf16x8 as_bf16x8(u32x4 w) { return __builtin_bit_cast(bf16x8, w); }
__device__ __forceinline__ f32x4 mfma16(bf16x8 a, bf16x8 b, f32x4 c) { return __builtin_amdgcn_mfma_f32_16x16x32_bf16(a, b, c, 0, 0, 0); }
__device__ __forceinline__ f32x16 mfma32(bf16x8 a, bf16x8 b, f32x16 c) { return __builtin_amdgcn_mfma_f32_32x32x16_bf16(a, b, c, 0, 0, 0); }
template <int N> __device__ __forceinline__ float row_shr(float x) {
    return __int_as_float(__builtin_amdgcn_update_dpp(0, __float_as_int(x), 0x110 + N, 0xf, 0xf, true));
}

typedef f32x4 Acc[2][2][4][2];

struct EpiYbf {
    static constexpr bool PERM = true, AFTER_DRAIN = false, KHOOK = false; static constexpr int KH0 = -1, KH1 = -1;
    bf16_t* Yb;
    __device__ __forceinline__ void operator()(Acc& acc, const Unit& u, int wr, int wc, int fr, int fq) const {
        const int row0 = u.pm * 256 + wr * 64 + fr, col0 = u.pn * 256 + wc * 32 + 8 * fq;
#pragma unroll
        for (int ai = 0; ai < 2; ++ai)
#pragma unroll
            for (int m = 0; m < 4; ++m)
#pragma unroll
                for (int bj = 0; bj < 2; ++bj) { const f32x4 a0 = acc[ai][bj][m][0], a1 = acc[ai][bj][m][1];
                    u32x4 w; w.x = cvt_pk_bf16(a0[0], a0[1]); w.y = cvt_pk_bf16(a0[2], a0[3]); w.z = cvt_pk_bf16(a1[0], a1[1]); w.w = cvt_pk_bf16(a1[2], a1[3]);
                    *(u32x4*)(Yb + (size_t)(row0 + ai * 128 + m * 16) * 1024 + col0 + bj * 128) = w; }
    }
};
struct EpiSwiglu {
    static constexpr bool PERM = true, AFTER_DRAIN = false, KHOOK = false; static constexpr int KH0 = -1, KH1 = -1;
    bf16_t* G;
    __device__ __forceinline__ void operator()(Acc& acc, const Unit& u, int wr, int wc, int fr, int fq) const {
        const int row0 = u.pm * 256 + wr * 64 + fr, col0 = u.pn * 128 + wc * 32 + 8 * fq;
#pragma unroll
        for (int ai = 0; ai < 2; ++ai)
#pragma unroll
            for (int m = 0; m < 4; ++m) {
                const f32x4 a0 = acc[ai][0][m][0], a1 = acc[ai][0][m][1], b0 = acc[ai][1][m][0], b1 = acc[ai][1][m][1];
                u32x4 w;
                w.x = cvt_pk_bf16(silu(a0[0]) * b0[0], silu(a0[1]) * b0[1]); w.y = cvt_pk_bf16(silu(a0[2]) * b0[2], silu(a0[3]) * b0[3]);
                w.z = cvt_pk_bf16(silu(a1[0]) * b1[0], silu(a1[1]) * b1[1]); w.w = cvt_pk_bf16(silu(a1[2]) * b1[2], silu(a1[3]) * b1[3]);
                *(u32x4*)(G + (size_t)(row0 + ai * 128 + m * 16) * FF + col0) = w;
            }
    }
};
struct EpiGates {
    static constexpr bool PERM = true, AFTER_DRAIN = false, KHOOK = false; static constexpr int KH0 = -1, KH1 = -1;
    bf16_t* GT;
    __device__ __forceinline__ void operator()(Acc& acc, const Unit& u, int wr, int wc, int fr, int fq) const {
        const int row0 = u.pm * 256 + wr * 64 + fr, col0 = u.pn * 256 + wc * 32 + 8 * fq;
#pragma unroll
        for (int ai = 0; ai < 2; ++ai)
#pragma unroll
            for (int m = 0; m < 4; ++m)
#pragma unroll
                for (int bj = 0; bj < 2; ++bj) {
                    const f32x4 a0 = acc[ai][bj][m][0], a1 = acc[ai][bj][m][1];
                    float v[8];
#pragma unroll
                    for (int j = 0; j < 4; ++j) { v[j] = fmaxf(sigm(a0[j]), 1e-20f); v[4 + j] = fmaxf(sigm(a1[j]), 1e-20f); }
                    u32x4 w; w.x = cvt_pk_bf16(v[0], v[1]); w.y = cvt_pk_bf16(v[2], v[3]); w.z = cvt_pk_bf16(v[4], v[5]); w.w = cvt_pk_bf16(v[6], v[7]);
                    *(u32x4*)(GT + (size_t)(row0 + ai * 128 + m * 16) * 3072 + col0 + bj * 128) = w;
                }
    }
};
struct EpiMerge {
    static constexpr bool PERM = true, AFTER_DRAIN = false, KHOOK = true; static constexpr int KH0 = 16, KH1 = 24;
    static __device__ __forceinline__ bool is_hook(int t) { return t == 4 || t == 8 || t == 12 || t == 16 || t == 24; }
    const bf16_t* GT; bf16_t* MG; const float* RR;
    __device__ __forceinline__ void khook(Acc& acc, const Unit& u, int t, int wr, int wc, int fr, int fq) const {
        int ofr = fr, ofq = fq; asm volatile("" : "+v"(ofr), "+v"(ofq));
        {
            const unsigned rbase = ((unsigned)(u.pm * 256 + wr * 64 + ofr) * 4u + (unsigned)(t >= 16 ? 3 : (t >> 2) - 1)) * 4u;
            if (t != 24) {
                const char* rb = (const char*)RR;
                float f[2][4];
#pragma unroll
                for (int ai = 0; ai < 2; ++ai)
#pragma unroll
                    for (int m = 0; m < 4; ++m) f[ai][m] = *(const float*)(rb + rbase + (unsigned)((ai * 128 + m * 16) * 16));
#pragma unroll
                for (int ai = 0; ai < 2; ++ai)
#pragma unroll
                    for (int m = 0; m < 4; ++m)
#pragma unroll
                        for (int bj = 0; bj < 2; ++bj) { acc[ai][bj][m][0] *= f[ai][m]; acc[ai][bj][m][1] *= f[ai][m]; }
                asm volatile("" ::: "memory");
            }
            if (t < 16) return;
        }
        const unsigned off0 = ((unsigned)(u.pm * 256 + wr * 64 + ofr) * 3072u + (unsigned)(u.pn * 256 + wc * 32 + 8 * ofq) + (t == 16 ? 0u : 1024u)) * 2u;
        const char* gb = (const char*)GT;
#pragma unroll
        for (int ai = 0; ai < 2; ++ai)
#pragma unroll
            for (int m = 0; m < 4; ++m)
#pragma unroll
                for (int bj = 0; bj < 2; ++bj) {
                    const unsigned o = off0 + (unsigned)((ai * 128 + m * 16) * 3072 + bj * 128) * 2u;
                    const u32x4 nu = *(const u32x4*)(gb + o), de = *(const u32x4*)(gb + o + 2048u);
                    f32x4& a0 = acc[ai][bj][m][0]; f32x4& a1 = acc[ai][bj][m][1];
                    a0[0] *= bflo(nu.x) * rcp(bflo(de.x)); a0[1] *= bfhi(nu.x) * rcp(bfhi(de.x)); a0[2] *= bflo(nu.y) * rcp(bflo(de.y)); a0[3] *= bfhi(nu.y) * rcp(bfhi(de.y));
                    a1[0] *= bflo(nu.z) * rcp(bflo(de.z)); a1[1] *= bfhi(nu.z) * rcp(bfhi(de.z)); a1[2] *= bflo(nu.w) * rcp(bflo(de.w)); a1[3] *= bfhi(nu.w) * rcp(bfhi(de.w));
                    asm volatile("" ::: "memory"); }
    }
    __device__ __forceinline__ void operator()(Acc& acc, const Unit& u, int wr, int wc, int fr, int fq) const {
        int ofr = fr, ofq = fq; asm volatile("" : "+v"(ofr), "+v"(ofq));
        const unsigned r0 = (unsigned)(u.pm * 256 + wr * 64 + ofr), c0 = (unsigned)(u.pn * 256 + wc * 32 + 8 * ofq);
        const char* gb = (const char*)GT; char* mb = (char*)MG;
#pragma unroll
        for (int ai = 0; ai < 2; ++ai)
#pragma unroll
            for (int m = 0; m < 4; ++m)
#pragma unroll
                for (int bj = 0; bj < 2; ++bj) {
                    const unsigned r = r0 + (unsigned)(ai * 128 + m * 16), cc = c0 + (unsigned)(bj * 128);
                    const u32x4 gc = *(const u32x4*)(gb + (r * 3072u + 2048u + cc) * 2u);
                    const f32x4 a0 = acc[ai][bj][m][0], a1 = acc[ai][bj][m][1];
                    u32x4 w;
                    w.x = cvt_pk_bf16(a0[0] * bflo(gc.x), a0[1] * bfhi(gc.x)); w.y = cvt_pk_bf16(a0[2] * bflo(gc.y), a0[3] * bfhi(gc.y));
                    w.z = cvt_pk_bf16(a1[0] * bflo(gc.z), a1[1] * bfhi(gc.z)); w.w = cvt_pk_bf16(a1[2] * bflo(gc.w), a1[3] * bfhi(gc.w));
                    *(u32x4*)(mb + (r * 1024u + cc) * 2u) = w;
                    asm volatile("" ::: "memory"); }
    }
};
struct EpiInProj {
    static constexpr bool PERM = true, AFTER_DRAIN = false, KHOOK = false; static constexpr int KH0 = -1, KH1 = -1;
    bf16_t *Q, *KT, *VT, *A2, *PIN, *XQ; float* DEC; const bf16_t *FLOW, *WFU; const float* b_f;
    template <bool SILU> __device__ __forceinline__ void plain(Acc& acc, const Unit& u, int wr, int wc, int fr, int fq, bf16_t* dst, int ld, int colbase, float sc) const {
        const int row0 = u.pm * 256 + wr * 64 + fr, col0 = colbase + wc * 32 + 8 * fq;
#pragma unroll
        for (int ai = 0; ai < 2; ++ai)
#pragma unroll
            for (int m = 0; m < 4; ++m)
#pragma unroll
                for (int bj = 0; bj < 2; ++bj) {
                    const f32x4 a0 = acc[ai][bj][m][0], a1 = acc[ai][bj][m][1];
                    float v[8];
#pragma unroll
                    for (int j = 0; j < 4; ++j) { v[j] = SILU ? silu(a0[j]) : a0[j] * sc; v[4 + j] = SILU ? silu(a1[j]) : a1[j] * sc; }
                    u32x4 w; w.x = cvt_pk_bf16(v[0], v[1]); w.y = cvt_pk_bf16(v[2], v[3]); w.z = cvt_pk_bf16(v[4], v[5]); w.w = cvt_pk_bf16(v[6], v[7]);
                    *(u32x4*)(dst + (size_t)(row0 + ai * 128 + m * 16) * ld + col0 + bj * 128) = w;
                }
    }
    __device__ __forceinline__ void vtile(Acc& acc, const Unit& u, int wr, int wc, int fr, int fq) const {
        const int h = u.pn - 4;
#pragma unroll
        for (int ai = 0; ai < 2; ++ai) {
            const int t0 = u.pm * 256 + ai * 128 + wr * 64, b = t0 >> 12, c = (t0 >> 6) & 63;
            bf16_t* base = VT + (size_t)((b * 4 + h) * 64 + c) * 256 * 64;
#pragma unroll
            for (int m = 0; m < 4; ++m) { const int s = 16 * m + fr;
#pragma unroll
                for (int bj = 0; bj < 2; ++bj)
#pragma unroll
                    for (int n = 0; n < 2; ++n) { const int vv = bj * 128 + wc * 32 + 8 * fq + 4 * n; const f32x4 a = acc[ai][bj][m][n];
                        const unsigned w0 = cvt_pk_bf16(a[0], a[1]), w1 = cvt_pk_bf16(a[2], a[3]);
                        base[(vv + 0) * 64 + s] = (bf16_t)(w0 & 0xffffu); base[(vv + 1) * 64 + s] = (bf16_t)(w0 >> 16);
                        base[(vv + 2) * 64 + s] = (bf16_t)(w1 & 0xffffu); base[(vv + 3) * 64 + s] = (bf16_t)(w1 >> 16); } }
        }
    }
    __device__ __forceinline__ void ktile(Acc& acc, const Unit& u, int wr, int wc, int fr, int fq) const {
        const int lane = threadIdx.x & 63;
        const bf16x8 zero8 = (bf16x8){0, 0, 0, 0, 0, 0, 0, 0};
#pragma unroll
        for (int ai = 0; ai < 2; ++ai) {
            const int t0 = u.pm * 256 + ai * 128 + wr * 64, b = t0 >> 12, c = (t0 >> 6) & 63;
            bf16x8 ff[4];
#pragma unroll
            for (int m = 0; m < 4; ++m) ff[m] = (fq < 2) ? ld16(FLOW + (size_t)(t0 + 16 * m + fr) * 16 + 8 * fq) : zero8;
#pragma unroll
            for (int bj = 0; bj < 2; ++bj) {
                const int h = (u.pn - 2) * 2 + bj;
                bf16_t* ktb = KT + (size_t)((b * 4 + h) * 64 + c) * 128 * 64;
#pragma unroll
                for (int n = 0; n < 2; ++n) {
                    const int cw = h * 128 + wc * 32 + 8 * (fr >> 2) + 4 * n + (fr & 3);
                    const bf16x8 wf = (fq < 2) ? ld16(WFU + (size_t)cw * 16 + 8 * fq) : zero8;
                    const int kk = wc * 32 + 8 * fq + 4 * n;
                    const f32x4 bias = *(const f32x4*)(b_f + h * 128 + kk);
                    f32x4 la[4];
#pragma unroll
                    for (int m = 0; m < 4; ++m) { f32x4 f = mfma16(wf, ff[m], (f32x4){0.f, 0.f, 0.f, 0.f});
#pragma unroll
                        for (int j = 0; j < 4; ++j) { const float x = f[j] + bias[j]; const float e = ex2(-fabsf(x) * LOG2E);
                            la[m][j] = (fminf(x, 0.f) - __log2f(1.f + e) * LN2) * (1.f / 16.f); } }
                    f32x4 run = (f32x4){0.f, 0.f, 0.f, 0.f};
#pragma unroll
                    for (int m = 0; m < 4; ++m)
#pragma unroll
                        for (int j = 0; j < 4; ++j) { float x = la[m][j];
                            x += row_shr<1>(x); x += row_shr<2>(x); x += row_shr<4>(x); x += row_shr<8>(x);
                            const float tot = __shfl(x, lane | 15);
                            la[m][j] = x + run[j]; run[j] += tot; }
#pragma unroll
                    for (int m = 0; m < 4; ++m) { const int s = 16 * m + fr; const f32x4 a = acc[ai][bj][m][n];
                        const unsigned w0 = cvt_pk_bf16(a[0] * ex2((run[0] - la[m][0]) * LOG2E), a[1] * ex2((run[1] - la[m][1]) * LOG2E));
                        const unsigned w1 = cvt_pk_bf16(a[2] * ex2((run[2] - la[m][2]) * LOG2E), a[3] * ex2((run[3] - la[m][3]) * LOG2E));
                        ktb[(kk + 0) * 64 + s] = (bf16_t)(w0 & 0xffffu); ktb[(kk + 1) * 64 + s] = (bf16_t)(w0 >> 16);
                        ktb[(kk + 2) * 64 + s] = (bf16_t)(w1 & 0xffffu); ktb[(kk + 3) * 64 + s] = (bf16_t)(w1 >> 16); }
                    if (fr == 0) *(f32x4*)(DEC + (size_t)(b * 64 + c) * 512 + h * 128 + kk) = (f32x4){ex2(run[0] * LOG2E), ex2(run[1] * LOG2E), ex2(run[2] * LOG2E), ex2(run[3] * LOG2E)};
                }
            }
        }
    }
    __device__ __forceinline__ void operator()(Acc& acc, const Unit& u, int wr, int wc, int fr, int fq) const {
        const int pn = u.pn;
        if (pn < 2) plain<false>(acc, u, wr, wc, fr, fq, Q, 512, pn * 256, QSCALE);
        else if (pn < 4) ktile(acc, u, wr, wc, fr, fq);
        else if (pn < 8) vtile(acc, u, wr, wc, fr, fq);
        else if (pn < 12) plain<true>(acc, u, wr, wc, fr, fq, A2, 2048, (pn - 8) * 256, 1.f);
        else if (pn < 14) plain<false>(acc, u, wr, wc, fr, fq, PIN, 512, (pn - 12) * 256, 1.f);
        else plain<false>(acc, u, wr, wc, fr, fq, XQ, 512, (pn - 14) * 256, XSCALE);
    }
};

struct Row { f32x4 v[4]; };
__device__ __forceinline__ Row ld_row(const float* p, int lane) { Row r; const float* q = p + 8 * lane;
    r.v[0] = *(const f32x4*)q; r.v[1] = *(const f32x4*)(q + 4); r.v[2] = *(const f32x4*)(q + 512); r.v[3] = *(const f32x4*)(q + 516); return r; }
__device__ __forceinline__ Row ld_row_nt(const float* p, int lane) { Row r; const f32x4* q = (const f32x4*)(p + 8 * lane);
    r.v[0] = __builtin_nontemporal_load(q); r.v[1] = __builtin_nontemporal_load(q + 1); r.v[2] = __builtin_nontemporal_load(q + 128); r.v[3] = __builtin_nontemporal_load(q + 129); return r; }
__device__ __forceinline__ void st_row(float* p, int lane, const Row& r) { float* q = p + 8 * lane;
    *(f32x4*)q = r.v[0]; *(f32x4*)(q + 4) = r.v[1]; *(f32x4*)(q + 512) = r.v[2]; *(f32x4*)(q + 516) = r.v[3]; }
__device__ __forceinline__ void st_row_nt(float* p, int lane, const Row& r) { f32x4* q = (f32x4*)(p + 8 * lane);
    __builtin_nontemporal_store(r.v[0], q); __builtin_nontemporal_store(r.v[1], q + 1); __builtin_nontemporal_store(r.v[2], q + 128); __builtin_nontemporal_store(r.v[3], q + 129); }
__device__ __forceinline__ Row ld_row_bf(const bf16_t* p, int lane) { Row r; const u32x4 a = __builtin_nontemporal_load((const u32x4*)(p + 8 * lane)), b = __builtin_nontemporal_load((const u32x4*)(p + 512 + 8 * lane));
    r.v[0] = (f32x4){bflo(a.x), bfhi(a.x), bflo(a.y), bfhi(a.y)}; r.v[1] = (f32x4){bflo(a.z), bfhi(a.z), bflo(a.w), bfhi(a.w)};
    r.v[2] = (f32x4){bflo(b.x), bfhi(b.x), bflo(b.y), bfhi(b.y)}; r.v[3] = (f32x4){bflo(b.z), bfhi(b.z), bflo(b.w), bfhi(b.w)}; return r; }
__device__ __forceinline__ float row_ss(const Row& r) { float s = 0.f;
#pragma unroll
    for (int j = 0; j < 4; ++j) s += (r.v[j][0] * r.v[j][0] + r.v[j][1] * r.v[j][1]) + (r.v[j][2] * r.v[j][2] + r.v[j][3] * r.v[j][3]);
    return wave_sum(s); }
__device__ __forceinline__ float rs_of(float ss) { return rsqrtf(ss * (1.f / 1024.f) + EPS); }
__device__ __forceinline__ Row mul_g(const Row& x, float rs, const Row& g) { Row r;
#pragma unroll
    for (int j = 0; j < 4; ++j) r.v[j] = x.v[j] * rs * g.v[j];
    return r; }
__device__ __forceinline__ void st_row_bf(const Row& h, bf16_t* out, int lane, LAS unsigned char* ldsrow) {
    u32x4 a, b; a.x = cvt_pk_bf16(h.v[0][0], h.v[0][1]); a.y = cvt_pk_bf16(h.v[0][2], h.v[0][3]); a.z = cvt_pk_bf16(h.v[1][0], h.v[1][1]); a.w = cvt_pk_bf16(h.v[1][2], h.v[1][3]);
    b.x = cvt_pk_bf16(h.v[2][0], h.v[2][1]); b.y = cvt_pk_bf16(h.v[2][2], h.v[2][3]); b.z = cvt_pk_bf16(h.v[3][0], h.v[3][1]); b.w = cvt_pk_bf16(h.v[3][2], h.v[3][3]);
    *(u32x4*)(out + 8 * lane) = a; *(u32x4*)(out + 512 + 8 * lane) = b;
    if (ldsrow) { *(LAS u32x4*)(ldsrow + 16 * lane) = a; *(LAS u32x4*)(ldsrow + 1024 + 16 * lane) = b; }
}

__device__ __forceinline__ void st_row_bf_nt(const Row& h, bf16_t* out, int lane) {
    u32x4 a, b; a.x = cvt_pk_bf16(h.v[0][0], h.v[0][1]); a.y = cvt_pk_bf16(h.v[0][2], h.v[0][3]); a.z = cvt_pk_bf16(h.v[1][0], h.v[1][1]); a.w = cvt_pk_bf16(h.v[1][2], h.v[1][3]);
    b.x = cvt_pk_bf16(h.v[2][0], h.v[2][1]); b.y = cvt_pk_bf16(h.v[2][2], h.v[2][3]); b.z = cvt_pk_bf16(h.v[3][0], h.v[3][1]); b.w = cvt_pk_bf16(h.v[3][2], h.v[3][3]);
    __builtin_nontemporal_store(a, (u32x4*)(out + 8 * lane)); __builtin_nontemporal_store(b, (u32x4*)(out + 512 + 8 * lane));
}

__device__ __forceinline__ unsigned pk2(float lo, float hi) { return cvt_pk_bf16(lo, hi); }
__device__ __forceinline__ void transpose_item(const float* W, int ldw, int k0, int ns0, bf16_t* WT, int ldt, int dr0, int dk0, LAS float* scr, int lane) {
    f32x4 v[8];
#pragma unroll
    for (int i = 0; i < 8; ++i) { const int kk = (lane >> 3) + 8 * i; v[i] = *(const f32x4*)(W + (size_t)(k0 + kk) * ldw + ns0 + 4 * (lane & 7)); }
#pragma unroll
    for (int i = 0; i < 8; ++i) { const int kk = (lane >> 3) + 8 * i; LAS float* q = scr + kk * 33 + 4 * (lane & 7); q[0] = v[i][0]; q[1] = v[i][1]; q[2] = v[i][2]; q[3] = v[i][3]; }
    asm volatile("s_waitcnt lgkmcnt(0)" ::: "memory");
    const int c = lane & 7;
#pragma unroll
    for (int j = 0; j < 4; ++j) { const int n = (lane >> 3) + 8 * j; const LAS float* s = scr + (8 * c) * 33 + n;
        u32x4 o; o.x = pk2(s[0 * 33], s[1 * 33]); o.y = pk2(s[2 * 33], s[3 * 33]); o.z = pk2(s[4 * 33], s[5 * 33]); o.w = pk2(s[6 * 33], s[7 * 33]);
        *(u32x4*)(WT + (size_t)(dr0 + n) * ldt + dk0 + 8 * c) = o; }
    asm volatile("s_waitcnt lgkmcnt(0)" ::: "memory");
}

struct Ptrs {
    const float* in[25]; float* out; unsigned char* ws; int ph_lo, ph_hi;
};
enum { I_X = 0, I_MEM, I_F1G, I_F1WI, I_F1WO, I_F1PG, I_MIXG, I_WIN, I_WFU, I_BF, I_GLAG, I_WPOOL, I_PSCALE, I_MEMG, I_WMKV, I_WUPG, I_WUPP, I_WUPX, I_WO, I_MIXPG, I_F2G, I_F2WI, I_F2WO, I_F2PG, I_FING };

__device__ __forceinline__ void p0_prologue(const Ptrs& P, LAS unsigned char* lds, int wave, int lane) {
    unsigned char* ws = P.ws;
    LAS float* scr = (LAS float*)(lds + wave * 16384);
    const int gw = blockIdx.x * 8 + wave, NGW = gridDim.x * 8;
    constexpr int I_FA = 16 * 176, I_FB = 44 * 32, I_IN = 16 * 224, I_UG = 16 * 32, I_UP = 8 * 32, I_SQ = 16 * 32, I_PL = 32;
    constexpr int NITEMS = 2 * (I_FA + I_FB) + I_IN + I_UG + 2 * I_UP + 2 * I_SQ + I_PL;
    for (int it = gw; it < NITEMS; it += NGW) {
        int r = it;
#pragma unroll
        for (int f = 0; f < 2; ++f) {
            if (r >= 0 && r < I_FA) { const int kb = r / 176, nb = r % 176, c = 32 * nb; const int dr = c < FF ? 256 * (c / 128) + (c % 128) : 256 * ((c - FF) / 128) + 128 + ((c - FF) % 128);
                transpose_item(P.in[f ? I_F2WI : I_F1WI], 2 * FF, 64 * kb, c, (bf16_t*)(ws + (f ? WS_W2A : WS_W1A)), 1024, dr, 64 * kb, scr, lane); r = -1; }
            if (r >= 0) r -= I_FA;
            if (r >= 0 && r < I_FB) { const int kb = r / 32, nb = r % 32;
                transpose_item(P.in[f ? I_F2WO : I_F1WO], 1024, 64 * kb, 32 * nb, (bf16_t*)(ws + (f ? WS_W2B : WS_W1B)), FF, 32 * nb, 64 * kb, scr, lane); r = -1; }
            if (r >= 0) r -= I_FB;
        }
        if (r < 0) continue;
        if (r < I_IN) { const int kb = r / 224, nb = r % 224, dr = 32 * nb, sc = dr < 3072 ? dr : dr + 16;
            transpose_item(P.in[I_WIN], 7184, 64 * kb, sc, (bf16_t*)(ws + WS_WIN), 1024, dr, 64 * kb, scr, lane); continue; } r -= I_IN;
        if (r < I_UG) { const int kb = r / 32, nb = r % 32; transpose_item(P.in[I_WUPG], 1024, 64 * kb, 32 * nb, (bf16_t*)(ws + WS_WUP), 2048, 32 * nb, 64 * kb, scr, lane); continue; } r -= I_UG;
        if (r < I_UP) { const int kb = r / 32, nb = r % 32; transpose_item(P.in[I_WUPP], 1024, 64 * kb, 32 * nb, (bf16_t*)(ws + WS_WUP), 2048, 32 * nb, 1024 + 64 * kb, scr, lane); continue; } r -= I_UP;
        if (r < I_UP) { const int kb = r / 32, nb = r % 32; transpose_item(P.in[I_WUPX], 1024, 64 * kb, 32 * nb, (bf16_t*)(ws + WS_WUP), 2048, 32 * nb, 1536 + 64 * kb, scr, lane); continue; } r -= I_UP;
        if (r < I_SQ) { const int kb = r / 32, nb = r % 32; transpose_item(P.in[I_WO], 1024, 64 * kb, 32 * nb, (bf16_t*)(ws + WS_WO), 1024, 32 * nb, 64 * kb, scr, lane); continue; } r -= I_SQ;
        if (r < I_SQ) { const int kb = r / 32, nb = r % 32; transpose_item(P.in[I_WMKV], 1024, 64 * kb, 32 * nb, (bf16_t*)(ws + WS_WMKV), 1024, 32 * nb, 64 * kb, scr, lane); continue; } r -= I_SQ;
        { const int g = r / 8, q = r % 8, kb = q / 4, nb = q % 4;
          transpose_item(P.in[I_WPOOL] + g * 16384, 128, 64 * kb, 32 * nb, (bf16_t*)(ws + WS_WPOOL) + g * 16384, 128, 32 * nb, 64 * kb, scr, lane); }
    }
    { const int gt = blockIdx.x * NTHREADS + threadIdx.x, NT = gridDim.x * NTHREADS;
      bf16_t* WF = (bf16_t*)(ws + WS_WF); bf16_t* WFU = (bf16_t*)(ws + WS_WFU);
      for (int i = gt; i < 16384; i += NT) { const int n = i >> 10, k = i & 1023; WF[i] = (bf16_t)(cvt_pk_bf16(P.in[I_WIN][(size_t)k * 7184 + 3072 + n], 0.f) & 0xffffu); }
      for (int i = gt; i < 8192; i += NT) { const int c = i >> 4, r = i & 15; WFU[i] = (bf16_t)(cvt_pk_bf16(P.in[I_WFU][r * 512 + c], 0.f) & 0xffffu); } }
    bf16_t* HN = (bf16_t*)(ws + WS_HN); bf16_t* MEMN = (bf16_t*)(ws + WS_MEMN);
    for (int m = gw; m < T + 2048; m += NGW) {
        if (m < T) { const Row x = ld_row_nt(P.in[I_X] + (size_t)m * 1024, lane); st_row_bf(mul_g(x, rs_of(row_ss(x)), ld_row(P.in[I_F1G], lane)), HN + (size_t)m * 1024, lane, (LAS unsigned char*)nullptr); }
        else { const int mm = m - T; const Row x = ld_row(P.in[I_MEM] + (size_t)mm * 1024, lane); st_row_bf(mul_g(x, rs_of(row_ss(x)), ld_row(P.in[I_MEMG], lane)), MEMN + (size_t)mm * 1024, lane, (LAS unsigned char*)nullptr); }
    }
}

constexpr int MKV_PITCH = 144, MKV_A = 64 * MKV_PITCH, MKV_STAGE = 192 * MKV_PITCH;
__device__ __forceinline__ void memkv_tile(const Ptrs& P, LAS unsigned char* lds, int wave, int lane) {
    unsigned char* ws = P.ws;
    const bf16_t* MEMN = (const bf16_t*)(ws + WS_MEMN); const bf16_t* W = (const bf16_t*)(ws + WS_WMKV);
    bf16_t* KM = (bf16_t*)(ws + WS_KM); bf16_t* VMT = (bf16_t*)(ws + WS_VMT);
    const int li = lane & 31, hh = lane >> 5, tid = threadIdx.x;
    for (int tile = blockIdx.x; tile < 256; tile += gridDim.x) {
        const int tm = tile >> 3, tn = tile & 7, m0 = 64 * tm + 32 * (wave & 1), n0 = 128 * tn + 32 * (wave >> 1);
        const bf16_t* src[3]; unsigned dst[3];
#pragma unroll
        for (int j = 0; j < 3; ++j) { const int p = tid + 512 * j, row = p >> 3, c16 = p & 7;
            src[j] = (row < 64 ? MEMN + (size_t)(64 * tm + row) * 1024 : W + (size_t)(128 * tn + row - 64) * 1024) + 8 * c16;
            dst[j] = (unsigned)(row * MKV_PITCH + 16 * c16); }
        u32x4 r[3];
#pragma unroll
        for (int j = 0; j < 3; ++j) r[j] = *(const u32x4*)(src[j]);
#pragma unroll
        for (int j = 0; j < 3; ++j) *(LAS u32x4*)(lds + dst[j]) = r[j];
        __syncthreads();
        f32x16 acc; for (int i = 0; i < 16; ++i) acc[i] = 0.f;
        const unsigned ao = (unsigned)((32 * (wave & 1) + li) * MKV_PITCH + 16 * hh), wo = (unsigned)(MKV_A + (32 * (wave >> 1) + li) * MKV_PITCH + 16 * hh);
#pragma unroll 1
        for (int kc = 0; kc < 16; ++kc) {
            LAS unsigned char* cur = lds + (kc & 1) * MKV_STAGE; LAS unsigned char* nxt = lds + ((kc + 1) & 1) * MKV_STAGE;
            if (kc + 1 < 16) {
#pragma unroll
                for (int j = 0; j < 3; ++j) r[j] = *(const u32x4*)(src[j] + 64 * (kc + 1)); }
#pragma unroll
            for (int st = 0; st < 4; ++st) { const bf16x8 af = *(const LAS bf16x8*)(cur + ao + 32 * st), wf = *(const LAS bf16x8*)(cur + wo + 32 * st);
                acc = tn < 4 ? mfma32(wf, af, acc) : mfma32(af, wf, acc); }
            if (kc + 1 < 16) {
#pragma unroll
                for (int j = 0; j < 3; ++j) *(LAS u32x4*)(nxt + dst[j]) = r[j]; }
            __syncthreads();
        }
        if (tn < 4) {
            const int m = m0 + li, b = m >> 8, key = m & 255, h = n0 >> 7;
#pragma unroll
            for (int rr = 0; rr < 4; ++rr) { const int d0 = (n0 & 127) + 8 * rr + 4 * hh;
                u32x2 w; w.x = cvt_pk_bf16_c(acc[4 * rr], acc[4 * rr + 1]); w.y = cvt_pk_bf16_c(acc[4 * rr + 2], acc[4 * rr + 3]);
                *(u32x2*)(KM + ((size_t)((b * 4 + h) * 256 + key)) * 128 + d0) = w; }
        } else {
            const int nn = n0 + li - 512, h = nn >> 7, dv = nn & 127;
#pragma unroll
            for (int rr = 0; rr < 4; ++rr) { const int m = m0 + 8 * rr + 4 * hh, b = m >> 8, key = m & 255;
                u32x2 w; w.x = cvt_pk_bf16_c(acc[4 * rr], acc[4 * rr + 1]); w.y = cvt_pk_bf16_c(acc[4 * rr + 2], acc[4 * rr + 3]);
                *(u32x2*)(VMT + ((size_t)((b * 4 + h) * 128 + dv)) * 256 + key) = w; }
        }
    }
}
constexpr int PR_WF = 0, PR_WFP = 2064, PR_ROWS = 16 * 2064;
struct Row2 { Row y[2], x[2]; };
template <int MODE> __device__ __forceinline__ void row_pass(const Ptrs& P, LAS unsigned char* lds, int wave, int lane) {
    unsigned char* ws = P.ws;
    const bf16_t* Yb = (const bf16_t*)(ws + WS_A2); bf16_t* HN = (bf16_t*)(ws + WS_HN);
    const float* xin = P.in[I_X];
    bf16_t* X1B = (bf16_t*)P.out; bf16_t* X2B = (bf16_t*)(ws + WS_A2 + (size_t)64 * MiB);
    const bf16_t* xb = MODE == 2 ? X1B : X2B;
    const Row gp = ld_row(P.in[MODE == 1 ? I_F1PG : (MODE == 2 ? I_MIXPG : I_F2PG)], lane), gn = ld_row(P.in[MODE == 1 ? I_MIXG : (MODE == 2 ? I_F2G : I_FING)], lane);
    const float sc = MODE == 2 ? 1.0f : 0.5f;
    bf16_t* FLOW = (bf16_t*)(ws + WS_FLOW);
    LAS unsigned char* rimg = lds + PR_ROWS + wave * 4096;
    const int fr = lane & 15, fq = lane >> 4;
    if (MODE == 1) {
        const u32x4* src = (const u32x4*)(ws + WS_WF);
        for (int i = threadIdx.x; i < 2048; i += NTHREADS) *(LAS u32x4*)(lds + PR_WF + (i >> 7) * PR_WFP + 16 * (i & 127)) = src[i];
        __syncthreads();
    }
    const int gw = blockIdx.x * 8 + wave, NGW = gridDim.x * 8, NIT = T / 2;
    Row2 cur, nxt;
#pragma unroll
    for (int i = 0; i < 2; ++i) { const size_t row = (size_t)gw * 2 + i; cur.y[i] = ld_row_bf(Yb + row * 1024, lane); cur.x[i] = MODE == 1 ? ld_row_nt(xin + row * 1024, lane) : ld_row_bf(xb + row * 1024, lane); }
    for (int item = gw; item < NIT; item += NGW) {
        const int ni = item + NGW < NIT ? item + NGW : item;
#pragma unroll
        for (int i = 0; i < 2; ++i) { const size_t row = (size_t)ni * 2 + i; nxt.y[i] = ld_row_bf(Yb + row * 1024, lane); nxt.x[i] = MODE == 1 ? ld_row_nt(xin + row * 1024, lane) : ld_row_bf(xb + row * 1024, lane); }
#pragma unroll
        for (int i = 0; i < 2; ++i) { const size_t row = (size_t)item * 2 + i;
            const float rsy = rs_of(row_ss(cur.y[i])) * sc;
#pragma unroll
            for (int j = 0; j < 4; ++j) cur.x[i].v[j] = cur.x[i].v[j] + cur.y[i].v[j] * rsy * gp.v[j];
            const Row h = mul_g(cur.x[i], rs_of(row_ss(cur.x[i])), gn);
            if (MODE == 3) st_row_nt(P.out + row * 1024, lane, h);
            else { st_row_bf_nt(cur.x[i], (MODE == 1 ? X1B : X2B) + row * 1024, lane); st_row_bf(h, HN + row * 1024, lane, MODE == 1 ? rimg + i * 2048 : (LAS unsigned char*)nullptr); }
        }
        if (MODE == 1) {
            asm volatile("s_waitcnt lgkmcnt(0)" ::: "memory");
            f32x4 a = (f32x4){0.f, 0.f, 0.f, 0.f};
#pragma unroll 8
            for (int s2 = 0; s2 < 32; ++s2) { const int k = 32 * s2 + 8 * fq;
                const bf16x8 hf = *(const LAS bf16x8*)(rimg + (fr & 1) * 2048 + k * 2);
                const bf16x8 wf = *(const LAS bf16x8*)(lds + PR_WF + fr * PR_WFP + k * 2);
                a = mfma16(wf, hf, a); }
            if (fr < 2) { u32x2 o; o.x = cvt_pk_bf16_c(a[0], a[1]); o.y = cvt_pk_bf16_c(a[2], a[3]); *(u32x2*)(FLOW + ((size_t)item * 2 + fr) * 16 + 4 * fq) = o; }
            asm volatile("s_waitcnt lgkmcnt(0)" ::: "memory");
        }
        cur = nxt;
    }
}

constexpr int GSTG = 41472, G_KB = 0, G_QB = 16384, G_VB = 32768, G_DB = 40960;
__device__ __forceinline__ void gla_block(const Ptrs& P, LAS unsigned char* lds, int bh, int vq, int wave, int lane) {
    unsigned char* ws = P.ws;
    const int b = bh >> 2, h = bh & 3, li = lane & 15, g = lane >> 4, vg = wave & 3, th = wave >> 2, j16 = 4 * vq + vg;
    const bf16_t* KTb = (const bf16_t*)(ws + WS_KT) + (size_t)bh * 64 * 8192;
    const bf16_t* Qb = (const bf16_t*)(ws + WS_Q) + (size_t)b * SEQ * 512 + h * 128;
    const bf16_t* VTb = (const bf16_t*)(ws + WS_VT) + ((size_t)bh * 64 * 256 + 64 * vq) * 64;
    const float* DCb = (const float*)(ws + WS_DEC) + (size_t)b * 64 * 512 + h * 128;
    float* OSS = (float*)(ws + WS_OSS);
    const int col = h * 256 + 16 * j16 + 4 * g;
    const f32x4 gn = *(const f32x4*)(P.in[I_GLAG] + col);
    bf16_t* arow = (bf16_t*)(ws + WS_A2) + ((size_t)b * SEQ + 32 * th + li) * 2048 + col;
    unsigned ksrc[2], qsrc[2];
#pragma unroll
    for (int i = 0; i < 2; ++i) { const int q = 2 * wave + i;
        { const int kk = 8 * q + (lane >> 3), lc = (lane & 7) ^ (kk & 7); ksrc[i] = (unsigned)(kk * 64 + lc * 8); }
        { const int t = 4 * q + (lane >> 4), l16 = (lane & 15) ^ (t & 15); qsrc[i] = (unsigned)(t * 512 + l16 * 8); } }
    unsigned vsrc; { const int vr = 8 * wave + (lane >> 3), lc = (lane & 7) ^ (vr & 7); vsrc = (unsigned)(vr * 64 + lc * 8); }
    const unsigned dsrc = (unsigned)((wave & 1) * 64 + lane);
#define GLA_ISSUE(cc, stg) do { const int _c = (cc); LAS unsigned char* _sb = lds + (stg) * GSTG; \
        const bf16_t* _kp = KTb + (size_t)_c * 8192; const bf16_t* _qp = Qb + (size_t)_c * 32768; const bf16_t* _vp = VTb + (size_t)_c * 16384; \
        _Pragma("unroll") for (int _i = 0; _i < 2; ++_i) __builtin_amdgcn_global_load_lds((const unsigned*)(_kp + ksrc[_i]), (LAS unsigned*)(_sb + G_KB + 1024 * (2 * wave + _i)), 16, 0, 0); \
        _Pragma("unroll") for (int _i = 0; _i < 2; ++_i) __builtin_amdgcn_global_load_lds((const unsigned*)(_qp + qsrc[_i]), (LAS unsigned*)(_sb + G_QB + 1024 * (2 * wave + _i)), 16, 0, 0); \
        __builtin_amdgcn_global_load_lds((const unsigned*)(_vp + vsrc), (LAS unsigned*)(_sb + G_VB + 1024 * wave), 16, 0, 0); \
        __builtin_amdgcn_global_load_lds((const unsigned*)(DCb + (size_t)_c * 512 + dsrc), (LAS unsigned*)(_sb + G_DB + (wave & 1) * 256), 4, 0, 0); } while (0)
    const int kx = li & 7;
    unsigned ka[2], va[2], qa[4], qb[4];
#pragma unroll
    for (int st = 0; st < 2; ++st) { ka[st] = (unsigned)(G_KB + li * 128 + (((4 * st + g) ^ kx) * 16)); va[st] = (unsigned)(G_VB + (16 * vg + li) * 128 + (((4 * st + g) ^ kx) * 16)); }
#pragma unroll
    for (int p = 0; p < 4; ++p) { const int ph = (4 * p + (g >> 1)) ^ li; qa[p] = (unsigned)(G_QB + li * 256 + ph * 16 + 8 * (g & 1)); qb[p] = (unsigned)(G_QB + li * 256 + (ph ^ 2) * 16 + 8 * (g & 1)); }
    const unsigned da = (unsigned)(G_DB + 16 * g);
    f32x4 S[8];
#pragma unroll
    for (int m = 0; m < 8; ++m) S[m] = (f32x4){0.f, 0.f, 0.f, 0.f};
    u32x2 oprev[2]; float sprev[2];
    oprev[0] = (u32x2){0u, 0u}; oprev[1] = (u32x2){0u, 0u}; sprev[0] = 0.f; sprev[1] = 0.f;
    u32x2 gA0, gA1, gB0, gB1;
    GLA_ISSUE(0, 0);
    { const bf16_t* gp0 = arow; const bf16_t* gp1 = gp0 + (size_t)16 * 2048;
      asm volatile("global_load_dwordx2 %0, %1, off" : "=v"(gA0) : "v"(gp0) : "memory");
      asm volatile("global_load_dwordx2 %0, %1, off" : "=v"(gA1) : "v"(gp1) : "memory"); }
    GLA_ISSUE(1, 1);
#define GLA_CHUNK(c, CUR0, CUR1, NXT0, NXT1) do { \
        asm volatile("s_waitcnt vmcnt(8)" ::: "memory");              \
        __builtin_amdgcn_s_barrier();                                 \
        asm volatile("" ::: "memory"); \
        if ((c) > 0) {                                                \
            _Pragma("unroll") for (int j = 0; j < 2; ++j) { bf16_t* ap = arow + (size_t)(((c) - 1) * 64 + 16 * j) * 2048; *(u32x2*)ap = oprev[j]; \
                if (g == 0) OSS[(((size_t)b * SEQ + ((c) - 1) * 64 + 32 * th + 16 * j + li) * 4 + h) * 16 + j16] = sprev[j]; } } \
        { const int cg = (c) + 1 < 64 ? (c) + 1 : 63; const bf16_t* gp0 = arow + (size_t)(cg * 64) * 2048; const bf16_t* gp1 = gp0 + (size_t)16 * 2048;     \
          asm volatile("global_load_dwordx2 %0, %1, off" : "=v"(NXT0) : "v"(gp0) : "memory"); \
          asm volatile("global_load_dwordx2 %0, %1, off" : "=v"(NXT1) : "v"(gp1) : "memory"); } \
        { const int cn = (c) + 2 < 64 ? (c) + 2 : 63; const int sn = ((c) + 2) % 3; GLA_ISSUE(cn, sn); } \
        LAS unsigned char* sbp = lds + ((c) % 3) * GSTG; \
        const bf16x8 vf0 = *(const LAS bf16x8*)(sbp + va[0]), vf1 = *(const LAS bf16x8*)(sbp + va[1]); \
        _Pragma("unroll") for (int m = 0; m < 8; ++m) { const f32x4 dc = *(const LAS f32x4*)(sbp + da + m * 64); S[m] = S[m] * dc; \
            S[m] = mfma16(*(const LAS bf16x8*)(sbp + ka[0] + m * 2048), vf0, S[m]); S[m] = mfma16(*(const LAS bf16x8*)(sbp + ka[1] + m * 2048), vf1, S[m]); } \
        bf16x8 sb[4]; \
        _Pragma("unroll") for (int p = 0; p < 4; ++p) { u32x4 w; w.x = cvt_pk_bf16_c(S[2 * p][0], S[2 * p][1]); w.y = cvt_pk_bf16_c(S[2 * p][2], S[2 * p][3]); \
            w.z = cvt_pk_bf16_c(S[2 * p + 1][0], S[2 * p + 1][1]); w.w = cvt_pk_bf16_c(S[2 * p + 1][2], S[2 * p + 1][3]); sb[p] = as_bf16x8(w); } \
        f32x4 o[2]; \
        _Pragma("unroll") for (int j = 0; j < 2; ++j) { const int tt = 2 * th + j; \
            o[j] = (f32x4){0.f, 0.f, 0.f, 0.f}; \
            _Pragma("unroll") for (int p = 0; p < 4; ++p) o[j] = mfma16(sb[p], cat8(*(const LAS s16x4*)(sbp + qa[p] + tt * 4096), *(const LAS s16x4*)(sbp + qb[p] + tt * 4096)), o[j]); } \
        asm volatile("s_waitcnt vmcnt(14)" : "+v"(CUR0), "+v"(CUR1) :: "memory");       \
        __builtin_amdgcn_sched_barrier(0); \
        _Pragma("unroll") for (int j = 0; j < 2; ++j) { const u32x2 gw = j ? CUR1 : CUR0; \
            float ss = (o[j][0] * o[j][0] + o[j][1] * o[j][1]) + (o[j][2] * o[j][2] + o[j][3] * o[j][3]); \
            ss = add_xor16(ss); ss = add_xor32(ss); \
            sprev[j] = ss; \
            oprev[j].x = cvt_pk_bf16(o[j][0] * bflo(gw.x) * gn[0], o[j][1] * bfhi(gw.x) * gn[1]); oprev[j].y = cvt_pk_bf16(o[j][2] * bflo(gw.y) * gn[2], o[j][3] * bfhi(gw.y) * gn[3]); } \
    } while (0)
#pragma unroll 1
    for (int c = 0; c < 64; c += 2) { GLA_CHUNK(c, gA0, gA1, gB0, gB1); GLA_CHUNK(c + 1, gB0, gB1, gA0, gA1); }
#undef GLA_CHUNK
    asm volatile("s_waitcnt vmcnt(0)" ::: "memory");
    __builtin_amdgcn_s_barrier();
    asm volatile("" ::: "memory");
#pragma unroll
    for (int j = 0; j < 2; ++j) { bf16_t* ap = arow + (size_t)(63 * 64 + 16 * j) * 2048; *(u32x2*)ap = oprev[j];
        if (g == 0) OSS[(((size_t)b * SEQ + 63 * 64 + 32 * th + 16 * j + li) * 4 + h) * 16 + j16] = sprev[j]; }
#undef GLA_ISSUE
}
__device__ __forceinline__ void xattn_unit(const Ptrs& P, int b, int h, int t0, int lane) {
    unsigned char* ws = P.ws;
    const bf16_t* XQ = (const bf16_t*)(ws + WS_XQ); bf16_t* A2 = (bf16_t*)(ws + WS_A2);
    const bf16_t* kmb = (const bf16_t*)(ws + WS_KM) + (size_t)(b * 4 + h) * 256 * 128; const bf16_t* vmb = (const bf16_t*)(ws + WS_VMT) + (size_t)(b * 4 + h) * 128 * 256;
    const int li = lane & 31, hh = lane >> 5;
    bf16x8 qf[8];
#pragma unroll
    for (int st = 0; st < 8; ++st) qf[st] = ld16(XQ + (size_t)(t0 + li) * 512 + h * 128 + 16 * st + 8 * hh);
    f32x16 X[8];
#pragma unroll
    for (int kt = 0; kt < 8; ++kt) {
#pragma unroll
        for (int i = 0; i < 16; ++i) X[kt][i] = 0.f;
#pragma unroll
        for (int st = 0; st < 8; ++st) X[kt] = mfma32(ld16(kmb + (size_t)(32 * kt + li) * 128 + 16 * st + 8 * hh), qf[st], X[kt]);
    }
    float mx = -3.0e38f;
#pragma unroll
    for (int kt = 0; kt < 8; ++kt)
#pragma unroll
        for (int i = 0; i < 16; ++i) mx = fmaxf(mx, X[kt][i]);
    mx = fmaxf(mx, __shfl_xor(mx, 32));
    float sum = 0.f;
#pragma unroll
    for (int kt = 0; kt < 8; ++kt)
#pragma unroll
        for (int i = 0; i < 16; ++i) { const float e = ex2(X[kt][i] - mx); X[kt][i] = e; sum += e; }
    sum += __shfl_xor(sum, 32);
    const float inv = 1.f / sum;
    bf16x8 pf[8][2];
#pragma unroll
    for (int kt = 0; kt < 8; ++kt)
#pragma unroll
        for (int s2 = 0; s2 < 2; ++s2) {
            u32x4 w; w.x = cvt_pk_bf16_c(X[kt][8 * s2 + 0], X[kt][8 * s2 + 1]); w.y = cvt_pk_bf16_c(X[kt][8 * s2 + 2], X[kt][8 * s2 + 3]);
            w.z = cvt_pk_bf16_c(X[kt][8 * s2 + 4], X[kt][8 * s2 + 5]); w.w = cvt_pk_bf16_c(X[kt][8 * s2 + 6], X[kt][8 * s2 + 7]);
            pf[kt][s2] = as_bf16x8(w); }
    bf16_t* orow = A2 + (size_t)(t0 + li) * 2048 + 1536 + h * 128 + 4 * hh;
#pragma unroll
    for (int nt = 0; nt < 4; ++nt) {
        f32x16 O;
#pragma unroll
        for (int i = 0; i < 16; ++i) O[i] = 0.f;
        const bf16_t* vr = vmb + (size_t)(32 * nt + li) * 256 + 4 * hh;
#pragma unroll
        for (int kt = 0; kt < 8; ++kt)
#pragma unroll
            for (int s2 = 0; s2 < 2; ++s2) O = mfma32(cat8(*(const s16x4*)(vr + 32 * kt + 16 * s2), *(const s16x4*)(vr + 32 * kt + 16 * s2 + 8)), pf[kt][s2], O);
#pragma unroll
        for (int rr = 0; rr < 4; ++rr) { u32x2 w; w.x = cvt_pk_bf16(O[4 * rr] * inv, O[4 * rr + 1] * inv); w.y = cvt_pk_bf16(O[4 * rr + 2] * inv, O[4 * rr + 3] * inv);
            *(u32x2*)(orow + 32 * nt + 8 * rr) = w; }
        asm volatile("" ::: "memory");
    }
}
__device__ __forceinline__ void xattn_unit_lds(const Ptrs& P, LAS unsigned char* lds, int h, int t0, int lane) {
    unsigned char* ws = P.ws;
    const bf16_t* XQ = (const bf16_t*)(ws + WS_XQ); bf16_t* A2 = (bf16_t*)(ws + WS_A2);
    const int li = lane & 31, hh = lane >> 5;
    bf16x8 qf[8];
#pragma unroll
    for (int st = 0; st < 8; ++st) qf[st] = ld16(XQ + (size_t)(t0 + li) * 512 + h * 128 + 16 * st + 8 * hh);
    f32x16 X[8];
    const unsigned kb = (unsigned)(li * 256), kx = (unsigned)(li & 15);
#pragma unroll
    for (int kt = 0; kt < 8; ++kt) {
#pragma unroll
        for (int i = 0; i < 16; ++i) X[kt][i] = 0.f;
#pragma unroll
        for (int st = 0; st < 8; ++st) X[kt] = mfma32(*(const LAS bf16x8*)(lds + kt * 8192 + kb + (((unsigned)(2 * st + hh) ^ kx) * 16)), qf[st], X[kt]);
    }
    float mx = -3.0e38f;
#pragma unroll
    for (int kt = 0; kt < 8; ++kt)
#pragma unroll
        for (int i = 0; i < 16; ++i) mx = fmaxf(mx, X[kt][i]);
    mx = fmaxf(mx, __shfl_xor(mx, 32));
    float sum = 0.f;
#pragma unroll
    for (int kt = 0; kt < 8; ++kt)
#pragma unroll
        for (int i = 0; i < 16; ++i) { const float e = ex2(X[kt][i] - mx); X[kt][i] = e; sum += e; }
    sum += __shfl_xor(sum, 32);
    const float inv = 1.f / sum;
    bf16x8 pf[8][2];
#pragma unroll
    for (int kt = 0; kt < 8; ++kt)
#pragma unroll
        for (int s2 = 0; s2 < 2; ++s2) {
            u32x4 w; w.x = cvt_pk_bf16_c(X[kt][8 * s2 + 0], X[kt][8 * s2 + 1]); w.y = cvt_pk_bf16_c(X[kt][8 * s2 + 2], X[kt][8 * s2 + 3]);
            w.z = cvt_pk_bf16_c(X[kt][8 * s2 + 4], X[kt][8 * s2 + 5]); w.w = cvt_pk_bf16_c(X[kt][8 * s2 + 6], X[kt][8 * s2 + 7]);
            pf[kt][s2] = as_bf16x8(w); }
    bf16_t* orow = A2 + (size_t)(t0 + li) * 2048 + 1536 + h * 128 + 4 * hh;
    const unsigned vx = (unsigned)li;
#pragma unroll
    for (int nt = 0; nt < 4; ++nt) {
        f32x16 O;
#pragma unroll
        for (int i = 0; i < 16; ++i) O[i] = 0.f;
        const unsigned vb = 65536u + (unsigned)((32 * nt + li) * 512) + 8u * (unsigned)hh;
#pragma unroll
        for (int kt = 0; kt < 8; ++kt)
#pragma unroll
            for (int s2 = 0; s2 < 2; ++s2) { const unsigned c0 = (unsigned)(4 * kt + 2 * s2);
                O = mfma32(cat8(*(const LAS s16x4*)(lds + vb + ((c0 ^ vx) * 16)), *(const LAS s16x4*)(lds + vb + (((c0 + 1) ^ vx) * 16))), pf[kt][s2], O); }
#pragma unroll
        for (int rr = 0; rr < 4; ++rr) { u32x2 w; w.x = cvt_pk_bf16(O[4 * rr] * inv, O[4 * rr + 1] * inv); w.y = cvt_pk_bf16(O[4 * rr + 2] * inv, O[4 * rr + 3] * inv);
            *(u32x2*)(orow + 32 * nt + 8 * rr) = w; }
        asm volatile("" ::: "memory");
    }
}
__device__ __forceinline__ void xattn_task(const Ptrs& P, LAS unsigned char* lds, int bh, int qtr, int wave, int lane) {
    unsigned char* ws = P.ws;
    const bf16_t* kmb = (const bf16_t*)(ws + WS_KM) + (size_t)bh * 256 * 128; const bf16_t* vmb = (const bf16_t*)(ws + WS_VMT) + (size_t)bh * 128 * 256;
    asm volatile("" : "+v"(lane));
#pragma unroll
    for (int i = 0; i < 8; ++i) { const int q = 8 * wave + i;
        const int row = 4 * q + (lane >> 4), lc = (lane & 15) ^ (row & 15);
        __builtin_amdgcn_global_load_lds((const unsigned*)(kmb + (size_t)row * 128 + lc * 8), (LAS unsigned*)(lds + 1024 * q), 16, 0, 0); }
#pragma unroll
    for (int i = 0; i < 8; ++i) { const int q = 8 * wave + i;
        const int row = 2 * q + (lane >> 5), lc = (lane & 31) ^ (row & 31);
        __builtin_amdgcn_global_load_lds((const unsigned*)(vmb + (size_t)row * 256 + lc * 8), (LAS unsigned*)(lds + 65536 + 1024 * q), 16, 0, 0); }
    asm volatile("s_waitcnt vmcnt(0)" ::: "memory");
    __syncthreads();
    const int b = bh >> 2, h = bh & 3;
#pragma unroll 1
    for (int it = 0; it < 4; ++it) { xattn_unit_lds(P, lds, h, b * SEQ + qtr * 1024 + it * 256 + wave * 32, lane); asm volatile("" ::: "memory"); }
    __syncthreads();
}
constexpr int POOL_PITCH = 272, POOL_WSCR = 48 * POOL_PITCH;
template <int G> __device__ __forceinline__ void pool_unit_g(const Ptrs& P, LAS unsigned char* sc, int t0, int lane) {
    constexpr int W = 2 << G, NR = W + 31, NP = NR * 16, NL = (NP + 63) / 64;
    unsigned char* ws = P.ws;
    const bf16_t* PIN = (const bf16_t*)(ws + WS_PIN); const bf16_t* WP = (const bf16_t*)(ws + WS_WPOOL) + G * 16384; bf16_t* A2 = (bf16_t*)(ws + WS_A2);
    const float* pscale = P.in[I_PSCALE] + G * 128;
    const int li = lane & 31, hh = lane >> 5, t = t0 + li, pos = t & (SEQ - 1), cnt = (pos + 1 < W) ? pos + 1 : W;
    const float icnt = 1.f / (float)cnt;
    { const int seq0 = t0 & ~(SEQ - 1);
      u32x4 v[NL];
#pragma unroll
      for (int i = 0; i < NL; ++i) { const int q = lane + 64 * i, j = q >> 4, c = q & 15; int r = t0 - (W - 1) + j; r = r < seq0 ? seq0 : r;
          if (q < NP) v[i] = *(const u32x4*)(PIN + (size_t)r * 512 + G * 128 + 8 * c); }
#pragma unroll
      for (int i = 0; i < NL; ++i) { const int q = lane + 64 * i, j = q >> 4, c = q & 15;
          if (q < NP) *(LAS u32x4*)(sc + j * POOL_PITCH + c * 16) = v[i]; }
      asm volatile("s_waitcnt lgkmcnt(0)" ::: "memory"); }
    f32x16 Dd[4];
#pragma unroll
    for (int nt = 0; nt < 4; ++nt)
#pragma unroll
        for (int i = 0; i < 16; ++i) Dd[nt][i] = 0.f;
    const LAS unsigned char* rowp = sc + (li + W - 1) * POOL_PITCH + 16 * hh;
#pragma unroll
    for (int st = 0; st < 8; ++st) {
        bf16x8 wq[4];
#pragma unroll
        for (int nt = 0; nt < 4; ++nt) wq[nt] = ld16(WP + (size_t)(32 * nt + li) * 128 + 16 * st + 8 * hh);
        float a[8] = {0.f, 0.f, 0.f, 0.f, 0.f, 0.f, 0.f, 0.f};
        const u32x4 own = *(const LAS u32x4*)(rowp + 32 * st);
#pragma unroll
        for (int i = 0; i < W; ++i) { const u32x4 x = *(const LAS u32x4*)(rowp + 32 * st - (i < cnt ? i : 0) * POOL_PITCH); const float wgt = (i < cnt) ? 1.f : 0.f;
            a[0] += wgt * bflo(x.x); a[1] += wgt * bfhi(x.x); a[2] += wgt * bflo(x.y); a[3] += wgt * bfhi(x.y);
            a[4] += wgt * bflo(x.z); a[5] += wgt * bfhi(x.z); a[6] += wgt * bflo(x.w); a[7] += wgt * bfhi(x.w); }
        u32x4 mw;
        mw.x = cvt_pk_bf16(a[0] * icnt - bflo(own.x), a[1] * icnt - bfhi(own.x)); mw.y = cvt_pk_bf16(a[2] * icnt - bflo(own.y), a[3] * icnt - bfhi(own.y));
        mw.z = cvt_pk_bf16(a[4] * icnt - bflo(own.z), a[5] * icnt - bfhi(own.z)); mw.w = cvt_pk_bf16(a[6] * icnt - bflo(own.w), a[7] * icnt - bfhi(own.w));
        asm volatile("s_nop 3" : "+v"(mw));
        const bf16x8 mf = as_bf16x8(mw);
#pragma unroll
        for (int nt = 0; nt < 4; ++nt) Dd[nt] = mfma32(wq[nt], mf, Dd[nt]);
    }
    asm volatile("s_waitcnt lgkmcnt(0)" ::: "memory");
    bf16_t* orow = A2 + (size_t)t * 2048 + 1024 + G * 128 + 4 * hh;
#pragma unroll
    for (int nt = 0; nt < 4; ++nt)
#pragma unroll
        for (int rr = 0; rr < 4; ++rr) { const f32x4 scv = *(const f32x4*)(pscale + 32 * nt + 8 * rr + 4 * hh);
            u32x2 o; o.x = cvt_pk_bf16(Dd[nt][4 * rr] * scv[0], Dd[nt][4 * rr + 1] * scv[1]); o.y = cvt_pk_bf16(Dd[nt][4 * rr + 2] * scv[2], Dd[nt][4 * rr + 3] * scv[3]);
            *(u32x2*)(orow + 32 * nt + 8 * rr) = o; }
}
__device__ __forceinline__ void gla_rfac_rows(const Ptrs& P) {
    const float* OSS = (const float*)(P.ws + WS_OSS); f32x4* RR = (f32x4*)(P.ws + WS_DEC);
    if (threadIdx.x < 128) for (int row = blockIdx.x * 128 + threadIdx.x; row < T; row += gridDim.x * 128) {
        float r[4];
#pragma unroll
        for (int h = 0; h < 4; ++h) { const float* op = OSS + ((size_t)row * 4 + h) * 16;
            const f32x4 s0 = *(const f32x4*)op, s1 = *(const f32x4*)(op + 4), s2 = *(const f32x4*)(op + 8), s3 = *(const f32x4*)(op + 12);
            const f32x4 s = (s0 + s1) + (s2 + s3);
            r[h] = rsqrtf(((s[0] + s[1]) + (s[2] + s[3])) * (1.f / 256.f) + EPS); }
        RR[row] = (f32x4){r[0] / r[1], r[1] / r[2], r[2] / r[3], r[3]};
    }
}

constexpr int CW_QUEUE = 12288;
__device__ __forceinline__ void p5_mixers(const Ptrs& P, LAS unsigned char* lds, int wave, int lane) {
    int gidx;
    if (gridDim.x == 256) { const int bx = (int)blockIdx.x;
        gidx = ((bx >> 3) & 1) == 0 ? (((bx & 7) * 4 + ((bx >> 4) >> 2)) * 4 + ((bx >> 4) & 3)) : -1; }
    else gidx = (int)blockIdx.x < 128 ? (int)blockIdx.x : -1;
    if (gidx >= 0) gla_block(P, lds, gidx >> 2, gidx & 3, wave, lane);
    unsigned* qh = (unsigned*)(P.ws + WS_CTL) + CW_QUEUE;
    for (;;) {
        if (threadIdx.x == 0) *(LAS unsigned*)(lds + LDSCTL_OFF + 512) = __hip_atomic_fetch_add(qh, 1u, __ATOMIC_RELAXED, __HIP_MEMORY_SCOPE_AGENT);
        __syncthreads();
        const unsigned it = *(const LAS unsigned*)(lds + LDSCTL_OFF + 512);
        __syncthreads();
        if (it >= 128u) break;
        xattn_task(P, lds, (int)it >> 2, (int)it & 3, wave, lane);
    }
    asm volatile("" ::: "memory");
#define POOL_LOOP(G) for (;;) { unsigned it = 0; if (lane == 0) it = __hip_atomic_fetch_add(qh + 64 * (1 + G), 1u, __ATOMIC_RELAXED, __HIP_MEMORY_SCOPE_AGENT); \
        it = (unsigned)__builtin_amdgcn_readfirstlane((int)it); if (it >= 1024u) break; pool_unit_g<G>(P, lds + wave * POOL_WSCR, (int)it * 32, lane); } asm volatile("" ::: "memory")
    POOL_LOOP(3); POOL_LOOP(2); POOL_LOOP(1); POOL_LOOP(0);
#undef POOL_LOOP
}
#define XB_TMO      128
#define XB_XCNT(j)  (256  + 64 * (j))
#define XB_XSUB(j)  (1280 + 64 * (j))
#define XB_XGEN(j)  (2304 + 64 * (j))
#define XB_TOP      3328
#define XB_TOPGEN   3392
#define XCD_BAR_WORDS 3456
#define XB_SPIN_CAP (1u << 18)

__device__ __forceinline__ unsigned xb_ld(unsigned* p)              { return __hip_atomic_load(p, __ATOMIC_RELAXED, __HIP_MEMORY_SCOPE_AGENT); }
__device__ __forceinline__ unsigned xb_add(unsigned* p, unsigned v) { return __hip_atomic_fetch_add(p, v, __ATOMIC_RELAXED, __HIP_MEMORY_SCOPE_AGENT); }
__device__ __forceinline__ unsigned xb_xcc_id() { return (unsigned)__builtin_amdgcn_s_getreg((3 << 11) | 20) & 0xFu; }
#define XB_SPIN(cond, bar) do { unsigned _sp = 0; while (cond) { __builtin_amdgcn_s_sleep(1); \
    if ((++_sp & 255u) == 0u) { if (xb_ld(&(bar)[XB_TMO])) break; if (_sp > XB_SPIN_CAP) { atomicAdd(&(bar)[XB_TMO], 1u); break; } } } } while (0)

struct XcdBarrier {
    unsigned* bar; unsigned x;
    volatile LAS unsigned* st;
};

__device__ __forceinline__ XcdBarrier xcd_barrier_post(unsigned* bar, volatile LAS unsigned* st) {
    XcdBarrier b; b.bar = bar; b.x = xb_xcc_id(); b.st = st;
    if (threadIdx.x == 0) (void)xb_add(&bar[XB_XCNT(b.x)], 1u);
    return b;
}
__device__ __forceinline__ void xcd_barrier_complete(unsigned* bar, unsigned x, unsigned& nloc, unsigned& nx) {
    const unsigned G = gridDim.x * gridDim.y * gridDim.z;
    unsigned sum, cnt, mine, sp = 0u;
    for (;;) {
        sum = 0u; cnt = 0u; mine = 0u;
#pragma unroll
        for (unsigned j = 0; j < 16; ++j) { const unsigned c = xb_ld(&bar[XB_XCNT(j)]); sum += c; cnt += (c > 0u) ? 1u : 0u; mine = (j == x) ? c : mine; }
        if (sum == G) break;
        __builtin_amdgcn_s_sleep(1);
        if ((++sp & 255u) == 0u) { if (xb_ld(&bar[XB_TMO])) break; if (sp > XB_SPIN_CAP) { atomicAdd(&bar[XB_TMO], 1u); break; } }
    }
    nloc = mine > 0u ? mine : 1u; nx = cnt > 0u ? cnt : 1u;
}

__device__ __forceinline__ void xcd_barrier(const XcdBarrier& b) {
    asm volatile("s_waitcnt vmcnt(0)" ::: "memory");
    __syncthreads();
    if (threadIdx.x == 0) {
        unsigned* bar = b.bar;
        __builtin_amdgcn_s_waitcnt(0);
        unsigned nloc = b.st[0], nx = b.st[1];
        if (nloc == 0u) { xcd_barrier_complete(bar, b.x, nloc, nx); b.st[0] = nloc; b.st[1] = nx; }
        const unsigned old = xb_add(&bar[XB_XSUB(b.x)], 1u);
        const unsigned gen = old / nloc;
        if (old + 1u == (gen + 1u) * nloc) {
            __builtin_amdgcn_fence(__ATOMIC_RELEASE, "agent");
            asm volatile("s_waitcnt vmcnt(0)" ::: "memory");
            const unsigned og = xb_add(&bar[XB_TOP], 1u);
            const unsigned tg = og / nx;
            if (og + 1u == (tg + 1u) * nx) xb_add(&bar[XB_TOPGEN], 1u);
            else XB_SPIN(xb_ld(&bar[XB_TOPGEN]) == tg, bar);
            __builtin_amdgcn_fence(__ATOMIC_ACQUIRE, "agent");
            xb_add(&bar[XB_XGEN(b.x)], 1u);
            asm volatile("s_waitcnt vmcnt(0)" ::: "memory");
        } else {
            XB_SPIN(xb_ld(&bar[XB_XGEN(b.x)]) == gen, bar);
            __builtin_amdgcn_fence(__ATOMIC_ACQUIRE, "agent");
            asm volatile("s_waitcnt vmcnt(0)" ::: "memory");
        }
    }
    __syncthreads();
}

constexpr int NPHASE = 14;
#ifndef DBL
#define DBL -1
#endif
constexpr int DBL_PHASE = DBL;
__global__ void __launch_bounds__(NTHREADS, 2) fwd(Ptrs P) {
    extern __shared__ __attribute__((aligned(16))) unsigned char lds_raw[];
    LAS unsigned char* lds = (LAS unsigned char*)lds_raw;
    const int tid = threadIdx.x, lane = tid & 63, wave = __builtin_amdgcn_readfirstlane(tid >> 6);
    unsigned char* ws = P.ws;
    cooperative_groups::grid_group grid = cooperative_groups::this_grid();
    const int lo = P.ph_lo, hi = P.ph_hi;
    volatile LAS unsigned* MISC = (volatile LAS unsigned*)(lds + LDSCTL_OFF);
    if (tid < 64) MISC[tid] = 0u;
    __syncthreads();
    XcdBarrier bar = xcd_barrier_post((unsigned*)(ws + WS_CTL) + CW_BAR, MISC + 8);
#define IN(k) (lo <= (k) && (k) < hi)
#define SEAM(k) do { if (IN(k) && IN((k) + 1)) xcd_barrier(bar); } while (0)
    if (lo > hi) grid.sync();
    const int G = gridDim.x, c = blockIdx.x;
    bf16_t* HN = (bf16_t*)(ws + WS_HN); bf16_t* Gb = (bf16_t*)(ws + WS_M); float* Y = (float*)(ws + WS_A2); bf16_t* A2 = (bf16_t*)(ws + WS_A2);
    if (IN(0)) p0_prologue(P, lds, wave, lane);
    if constexpr (DBL_PHASE == 0) { if (IN(0)) { xcd_barrier(bar); p0_prologue(P, lds, wave, lane); } }
    SEAM(0);
    if (IN(1)) { pg8::Gemm g{HN, (const bf16_t*)(ws + WS_W1A), T, 2 * FF, D}; pg8::StaticOrder S; S.init(T, 2 * FF, G, c); EpiSwiglu E{Gb};
        pg8::gemm_phase<EpiSwiglu, pg8::StaticOrder, true, true>(lds, g, S, E); }
    if constexpr (DBL_PHASE == 1) { if (IN(1)) { xcd_barrier(bar); { pg8::Gemm g{HN, (const bf16_t*)(ws + WS_W1A), T, 2 * FF, D}; pg8::StaticOrder S; S.init(T, 2 * FF, G, c); EpiSwiglu E{Gb};
        pg8::gemm_phase<EpiSwiglu, pg8::StaticOrder, true, true>(lds, g, S, E); } } }
    SEAM(1);
    if (IN(2)) { pg8::Gemm g{Gb, (const bf16_t*)(ws + WS_W1B), T, D, FF}; pg8::StaticOrder S; S.init(T, D, G, c); EpiYbf E{(bf16_t*)Y};
        pg8::gemm_phase<EpiYbf, pg8::StaticOrder, true, true>(lds, g, S, E); }
    if constexpr (DBL_PHASE == 2) { if (IN(2)) { xcd_barrier(bar); { pg8::Gemm g{Gb, (const bf16_t*)(ws + WS_W1B), T, D, FF}; pg8::StaticOrder S; S.init(T, D, G, c); EpiYbf E{(bf16_t*)Y};
        pg8::gemm_phase<EpiYbf, pg8::StaticOrder, true, true>(lds, g, S, E); } } }
    SEAM(2);
    if (IN(3)) { memkv_tile(P, lds, wave, lane); row_pass<1>(P, lds, wave, lane); }
    if constexpr (DBL_PHASE == 3) { if (IN(3)) { xcd_barrier(bar); { memkv_tile(P, lds, wave, lane); row_pass<1>(P, lds, wave, lane); } } }
    SEAM(3);
    if (IN(4)) { pg8::Gemm g{HN, (const bf16_t*)(ws + WS_WIN), T, 4096, D}; pg8::StaticOrder S; S.init(T, 4096, G, c);
        EpiInProj E{(bf16_t*)(ws + WS_Q), (bf16_t*)(ws + WS_KT), (bf16_t*)(ws + WS_VT), A2, (bf16_t*)(ws + WS_PIN), (bf16_t*)(ws + WS_XQ), (float*)(ws + WS_DEC),
                    (const bf16_t*)(ws + WS_FLOW), (const bf16_t*)(ws + WS_WFU), P.in[I_BF]};
        pg8::gemm_phase<EpiInProj, pg8::StaticOrder, true, true>(lds, g, S, E); }
    if constexpr (DBL_PHASE == 4) { if (IN(4)) { xcd_barrier(bar); { pg8::Gemm g{HN, (const bf16_t*)(ws + WS_WIN), T, 4096, D}; pg8::StaticOrder S; S.init(T, 4096, G, c);
        EpiInProj E{(bf16_t*)(ws + WS_Q), (bf16_t*)(ws + WS_KT), (bf16_t*)(ws + WS_VT), A2, (bf16_t*)(ws + WS_PIN), (bf16_t*)(ws + WS_XQ), (float*)(ws + WS_DEC),
                    (const bf16_t*)(ws + WS_FLOW), (const bf16_t*)(ws + WS_WFU), P.in[I_BF]};
        pg8::gemm_phase<EpiInProj, pg8::StaticOrder, true, true>(lds, g, S, E); } } }
    SEAM(4);
    if (IN(5)) p5_mixers(P, lds, wave, lane);
    SEAM(5);
    if (IN(7)) { { pg8::Gemm g{HN, (const bf16_t*)(ws + WS_WIN) + (size_t)4096 * 1024, T, 3072, D}; pg8::StaticOrder S; S.init(T, 3072, G, c); EpiGates E{(bf16_t*)(ws + WS_M)};
        pg8::gemm_phase<EpiGates, pg8::StaticOrder, true, true>(lds, g, S, E); }
        gla_rfac_rows(P); }
    SEAM(7);
    if (IN(8)) { pg8::Gemm g{A2, (const bf16_t*)(ws + WS_WUP), T, D, 2048}; pg8::StaticOrder S; S.init(T, D, G, c); EpiMerge E{(const bf16_t*)(ws + WS_M), HN, (const float*)(ws + WS_DEC)};
        pg8::gemm_phase<EpiMerge, pg8::StaticOrder, true, true>(lds, g, S, E); }
    if constexpr (DBL_PHASE == 8) { if (IN(8)) { xcd_barrier(bar); { pg8::Gemm g{A2, (const bf16_t*)(ws + WS_WUP), T, D, 2048}; pg8::StaticOrder S; S.init(T, D, G, c); EpiMerge E{(const bf16_t*)(ws + WS_M), HN, (const float*)(ws + WS_DEC)};
        pg8::gemm_phase<EpiMerge, pg8::StaticOrder, true, true>(lds, g, S, E); } } }
    SEAM(8);
    if (IN(9)) { pg8::Gemm g{HN, (const bf16_t*)(ws + WS_WO), T, D, D}; pg8::StaticOrder S; S.init(T, D, G, c); EpiYbf E{(bf16_t*)Y};
        pg8::gemm_phase<EpiYbf, pg8::StaticOrder, true, true>(lds, g, S, E); }
    if constexpr (DBL_PHASE == 9) { if (IN(9)) { xcd_barrier(bar); { pg8::Gemm g{HN, (const bf16_t*)(ws + WS_WO), T, D, D}; pg8::StaticOrder S; S.init(T, D, G, c); EpiYbf E{(bf16_t*)Y};
        pg8::gemm_phase<EpiYbf, pg8::StaticOrder, true, true>(lds, g, S, E); } } }
    SEAM(9);
    if (IN(10)) row_pass<2>(P, lds, wave, lane);
    SEAM(10);
    if (IN(11)) { pg8::Gemm g{HN, (const bf16_t*)(ws + WS_W2A), T, 2 * FF, D}; pg8::StaticOrder S; S.init(T, 2 * FF, G, c); EpiSwiglu E{Gb};
        pg8::gemm_phase<EpiSwiglu, pg8::StaticOrder, true, true>(lds, g, S, E); }
    if constexpr (DBL_PHASE == 11) { if (IN(11)) { xcd_barrier(bar); { pg8::Gemm g{HN, (const bf16_t*)(ws + WS_W2A), T, 2 * FF, D}; pg8::StaticOrder S; S.init(T, 2 * FF, G, c); EpiSwiglu E{Gb};
        pg8::gemm_phase<EpiSwiglu, pg8::StaticOrder, true, true>(lds, g, S, E); } } }
    SEAM(11);
    if (IN(12)) { pg8::Gemm g{Gb, (const bf16_t*)(ws + WS_W2B), T, D, FF}; pg8::StaticOrder S; S.init(T, D, G, c); EpiYbf E{(bf16_t*)Y};
        pg8::gemm_phase<EpiYbf, pg8::StaticOrder, true, true>(lds, g, S, E); }
    if constexpr (DBL_PHASE == 12) { if (IN(12)) { xcd_barrier(bar); { pg8::Gemm g{Gb, (const bf16_t*)(ws + WS_W2B), T, D, FF}; pg8::StaticOrder S; S.init(T, D, G, c); EpiYbf E{(bf16_t*)Y};
        pg8::gemm_phase<EpiYbf, pg8::StaticOrder, true, true>(lds, g, S, E); } } }
    SEAM(12);
    if (IN(13)) row_pass<3>(P, lds, wave, lane);
#undef IN
#undef SEAM
}
}
#ifndef MK_MODE
#define MK_MODE 0
#endif
#if MK_MODE == 1
namespace dbg {
using mk::bf16_t;
__device__ __forceinline__ float b2f(bf16_t u) { return __uint_as_float((unsigned)u << 16); }
template <class F> __global__ void cmp_k(F f, const float* ref, int ldr, int rows, int cols, float* slot) {
    float d = 0.f, s = 0.f;
    for (size_t i = (size_t)blockIdx.x * 256 + threadIdx.x; i < (size_t)rows * cols; i += (size_t)gridDim.x * 256) {
        const int r = (int)(i / cols), c = (int)(i % cols); const float a = f(r, c), b = ref[(size_t)r * ldr + c]; d += (a - b) * (a - b); s += b * b; }
    for (int o = 32; o > 0; o >>= 1) { d += __shfl_down(d, o); s += __shfl_down(s, o); }
    if ((threadIdx.x & 63) == 0) { atomicAdd(slot, d); atomicAdd(slot + 1, s); }
}
template <class F> inline void cmp(hipStream_t st, F f, const float* ref, int ldr, int rows, int cols, float* slots, int k) {
    hipLaunchKernelGGL(cmp_k<F>, dim3(256), dim3(256), 0, st, f, ref, ldr, rows, cols, slots + 2 * k);
}
__global__ void report(const float* slots, int n, float tol, float* out) {
    if (threadIdx.x == 0 && blockIdx.x == 0) for (int k = 0; k < n; ++k) { const float rv = slots[2 * k] / fmaxf(slots[2 * k + 1], 1e-30f); if (!(rv < tol)) { out[0] = 1000.f * (float)(k + 1); break; } }
}
__global__ void sigm_k(const float* proj, float* o, int R) { const size_t i = (size_t)blockIdx.x * 256 + threadIdx.x; if (i < (size_t)R * 3072) { const size_t t = i / 3072; const int c = (int)(i % 3072); o[i] = nv::sigm_f(proj[t * 7184 + nv::OGT + c]); } }
__global__ void silu_k(const float* proj, float* o, int R) { const size_t i = (size_t)blockIdx.x * 256 + threadIdx.x; if (i < (size_t)R * 1024) { const size_t t = i / 1024; const int c = (int)(i % 1024); o[i] = nv::silu_f(proj[t * 7184 + nv::OG + c]); } }
}
#endif

extern "C" void kernel_launch(void* const* d_in, const int* in_sizes, int n_in, void* d_out, int out_size, void* d_ws, size_t ws_size, hipStream_t stream) {
    static int grid = 0;
    if (grid == 0) {
        if (n_in != 25 || out_size != mk::T * 1024 || ws_size < mk::WS_END) { fprintf(stderr, "kernel_launch: unexpected shapes (n_in %d out %d ws %zu)\n", n_in, out_size, ws_size); grid = -1; return; }
        int dev = 0, cus = 0, per_cu = 0;
        hipGetDevice(&dev); hipDeviceGetAttribute(&cus, hipDeviceAttributeMultiprocessorCount, dev);
        if (hipFuncSetAttribute((const void*)mk::fwd, hipFuncAttributeMaxDynamicSharedMemorySize, mk::LDS_BYTES) != hipSuccess) { fprintf(stderr, "kernel_launch: hipFuncSetAttribute failed\n"); grid = -1; return; }
        hipOccupancyMaxActiveBlocksPerMultiprocessor(&per_cu, (const void*)mk::fwd, mk::NTHREADS, mk::LDS_BYTES);
        if (per_cu < 1) { fprintf(stderr, "kernel_launch: occupancy query says %d blocks/CU\n", per_cu); (void)hipGetLastError(); per_cu = 1; }
        grid = cus;
        if (grid != 256) fprintf(stderr, "kernel_launch: note: %d CUs\n", grid);
    }
    if (grid < 0) return;
    mk::Ptrs p{};
    for (int i = 0; i < 25; ++i) p.in[i] = (const float*)d_in[i];
    p.out = (float*)d_out; p.ws = (unsigned char*)d_ws;
#if MK_MODE == 0
    p.ph_lo = 0; p.ph_hi = mk::NPHASE;
    if (hipMemsetAsync((char*)d_ws + mk::WS_CTL, 0, mk::CTL_BYTES, stream) != hipSuccess) { fprintf(stderr, "kernel_launch: memset failed\n"); return; }
    void* args[] = {&p};
    hipError_t e = hipLaunchCooperativeKernel((const void*)mk::fwd, dim3(grid), dim3(mk::NTHREADS), args, mk::LDS_BYTES, stream);
    if (e != hipSuccess) fprintf(stderr, "kernel_launch: cooperative launch failed: %s\n", hipGetErrorString(e));
#else
    constexpr int BC = 5, R = 512; constexpr size_t row0 = (size_t)BC * 4096;
    unsigned char* ws = (unsigned char*)d_ws;
    hipMemsetAsync(ws + mk::WS_CTL, 0, mk::CTL_BYTES, stream);
    float* slots = (float*)(ws + mk::WS_CTL + 1024);
    nv::Bufs b; const size_t nf = nv::carve(b, (float*)(ws + mk::WS_END), R, 256);
    if (mk::WS_END + nf * 4 > ws_size) { fprintf(stderr, "debug: ws too small (%zu)\n", ws_size); return; }
    auto F = [&](int i) { return (const float*)d_in[i]; };
    auto PH = [&](int k) { p.ph_lo = k; p.ph_hi = k + 1; hipLaunchKernelGGL(mk::fwd, dim3(grid), dim3(mk::NTHREADS), mk::LDS_BYTES, stream, p); };
    using mk::bf16_t; using dbg::b2f;
    const float* x = F(0) + row0 * 1024; float* out = (float*)d_out;
    const bf16_t* HN = (const bf16_t*)(ws + mk::WS_HN); const bf16_t* Gb = (const bf16_t*)(ws + mk::WS_M); const float* Y = (const float*)(ws + mk::WS_A2);
    const bf16_t* A2 = (const bf16_t*)(ws + mk::WS_A2);
    int k = 0;
    PH(0);
    hipLaunchKernelGGL(nv::rmsnorm, dim3(R), dim3(256), 0, stream, x, 1024, F(2), b.h, 1024, 1024);
    dbg::cmp(stream, [=] __device__(int r, int c) { return b2f(HN[(row0 + r) * 1024 + c]); }, b.h, 1024, R, 1024, slots, k++);
    hipLaunchKernelGGL(nv::rmsnorm, dim3(256), dim3(256), 0, stream, F(1) + (size_t)BC * 256 * 1024, 1024, F(13), b.memn, 1024, 1024);
    { const bf16_t* MEMN = (const bf16_t*)(ws + mk::WS_MEMN);
      dbg::cmp(stream, [=] __device__(int r, int c) { return b2f(MEMN[((size_t)BC * 256 + r) * 1024 + c]); }, b.memn, 1024, 256, 1024, slots, k++); }
    PH(1);
    nv::gemm(stream, b.h, 1024, F(3), 5632, b.big, 5632, R, 5632, 1024);
    hipLaunchKernelGGL(nv::swiglu, dim3((R * 2816 + 255) / 256), dim3(256), 0, stream, b.big, b.gg, R, 2816);
    dbg::cmp(stream, [=] __device__(int r, int c) { return b2f(Gb[(row0 + r) * 2816 + c]); }, b.gg, 2816, R, 2816, slots, k++);
    PH(2);
    nv::gemm(stream, b.gg, 2816, F(4), 1024, b.y, 1024, R, 1024, 2816);
    dbg::cmp(stream, [=] __device__(int r, int c) { return Y[(row0 + r) * 1024 + c]; }, b.y, 1024, R, 1024, slots, k++);
    PH(3);
    hipLaunchKernelGGL(nv::resid_norm, dim3(R), dim3(256), 0, stream, x, b.y, F(5), 0.5f, b.xo);
    dbg::cmp(stream, [=] __device__(int r, int c) { return out[(row0 + r) * 1024 + c]; }, b.xo, 1024, R, 1024, slots, k++);
    hipLaunchKernelGGL(nv::rmsnorm, dim3(R), dim3(256), 0, stream, b.xo, 1024, F(6), b.h, 1024, 1024);
    dbg::cmp(stream, [=] __device__(int r, int c) { return b2f(HN[(row0 + r) * 1024 + c]); }, b.h, 1024, R, 1024, slots, k++);
    nv::gemm(stream, b.h, 1024, F(7), 7184, b.big, 7184, R, 7184, 1024);
    { const bf16_t* FLOW = (const bf16_t*)(ws + mk::WS_FLOW);
      dbg::cmp(stream, [=] __device__(int r, int c) { return b2f(FLOW[(row0 + r) * 16 + c]); }, b.big + nv::OF, 7184, R, 16, slots, k++); }
    nv::gemm(stream, b.memn, 1024, F(14), 1024, b.kv, 1024, 256, 1024, 1024);
    { const bf16_t* KM = (const bf16_t*)(ws + mk::WS_KM); const bf16_t* VMT = (const bf16_t*)(ws + mk::WS_VMT);
      dbg::cmp(stream, [=] __device__(int r, int c) { return b2f(KM[((size_t)(BC * 4 + (c >> 7)) * 256 + r) * 128 + (c & 127)]); }, b.kv, 1024, 256, 512, slots, k++);
      dbg::cmp(stream, [=] __device__(int r, int c) { return b2f(VMT[((size_t)(BC * 4 + (c >> 7)) * 128 + (c & 127)) * 256 + r]); }, b.kv + 512, 1024, 256, 512, slots, k++); }
    PH(4);
    hipLaunchKernelGGL(nv::gla_prep, dim3((R / 64 * 512 + 255) / 256), dim3(256), 0, stream, b.big, F(8), F(9), b.kt, b.dec, R);
    { const bf16_t* Q = (const bf16_t*)(ws + mk::WS_Q); const bf16_t* KT = (const bf16_t*)(ws + mk::WS_KT); const bf16_t* VT = (const bf16_t*)(ws + mk::WS_VT);
      const bf16_t* PIN = (const bf16_t*)(ws + mk::WS_PIN); const bf16_t* XQ = (const bf16_t*)(ws + mk::WS_XQ); const float* DEC = (const float*)(ws + mk::WS_DEC);
      dbg::cmp(stream, [=] __device__(int r, int c) { return b2f(Q[(row0 + r) * 512 + c]) * (1.f / mk::QSCALE); }, b.big + nv::OQ, 7184, R, 512, slots, k++);
      dbg::cmp(stream, [=] __device__(int r, int c) { return b2f(KT[((size_t)((BC * 4 + (c >> 7)) * 64 + (r >> 6)) * 128 + (c & 127)) * 64 + (r & 63)]); }, b.kt, 512, R, 512, slots, k++);
      dbg::cmp(stream, [=] __device__(int r, int c) { return DEC[((size_t)BC * 64 + r) * 512 + c]; }, b.dec, 512, R / 64, 512, slots, k++);
      dbg::cmp(stream, [=] __device__(int r, int c) { return b2f(VT[((size_t)((BC * 4 + (c >> 8)) * 64 + (r >> 6)) * 256 + (c & 255)) * 64 + (r & 63)]); }, b.big + nv::OV, 7184, R, 1024, slots, k++);
      hipLaunchKernelGGL(dbg::silu_k, dim3((R * 1024 + 255) / 256), dim3(256), 0, stream, b.big, b.o, R);
      dbg::cmp(stream, [=] __device__(int r, int c) { return b2f(A2[(row0 + r) * 2048 + c]); }, b.o, 1024, R, 1024, slots, k++);
      dbg::cmp(stream, [=] __device__(int r, int c) { return b2f(PIN[(row0 + r) * 512 + c]); }, b.big + nv::OP, 7184, R, 512, slots, k++);
      dbg::cmp(stream, [=] __device__(int r, int c) { return b2f(XQ[(row0 + r) * 512 + c]) * (1.f / mk::XSCALE); }, b.big + nv::OX, 7184, R, 512, slots, k++); }
    PH(5);
    hipLaunchKernelGGL(nv::gla_scan, dim3(32), dim3(256), 0, stream, b.big, b.kt, b.dec, b.o, R);
    hipLaunchKernelGGL(nv::gla_out, dim3(R), dim3(256), 0, stream, b.o, b.big, F(10), b.ga);
    hipLaunchKernelGGL(nv::pool_mix, dim3((R * 512 + 255) / 256), dim3(256), 0, stream, b.big, b.mixed, R);
    hipLaunchKernelGGL(nv::pool_lin, dim3((R * 512 + 255) / 256), dim3(256), 0, stream, b.mixed, F(11), F(12), b.py, R);
    hipLaunchKernelGGL(nv::xattn, dim3(R * 4), dim3(256), 0, stream, b.big, b.kv, b.xa);
    dbg::cmp(stream, [=] __device__(int r, int c) { return b2f(A2[(row0 + r) * 2048 + 1024 + c]); }, b.py, 512, R, 512, slots, k++);
    dbg::cmp(stream, [=] __device__(int r, int c) { return b2f(A2[(row0 + r) * 2048 + 1536 + c]); }, b.xa, 512, R, 512, slots, k++);
    PH(6);
    { const bf16_t* GT = (const bf16_t*)(ws + mk::WS_M);
      hipLaunchKernelGGL(dbg::sigm_k, dim3((R * 3072 + 255) / 256), dim3(256), 0, stream, b.big, b.ya, R);
      dbg::cmp(stream, [=] __device__(int r, int c) { return b2f(GT[(row0 + r) * 3072 + c]); }, b.ya, 3072, R, 3072, slots, k++);
      dbg::cmp(stream, [=] __device__(int r, int c) { return b2f(A2[(row0 + r) * 2048 + c]); }, b.ga, 1024, R, 1024, slots, k++); }
    PH(7);
    nv::gemm(stream, b.ga, 1024, F(15), 1024, b.ya, 1024, R, 1024, 1024);
    nv::gemm(stream, b.py, 512, F(16), 1024, b.yb, 1024, R, 1024, 512);
    nv::gemm(stream, b.xa, 512, F(17), 1024, b.yc, 1024, R, 1024, 512);
    hipLaunchKernelGGL(nv::merge, dim3((R * 1024 + 255) / 256), dim3(256), 0, stream, b.big, b.ya, b.yb, b.yc, b.mg, R);
    dbg::cmp(stream, [=] __device__(int r, int c) { return b2f(HN[(row0 + r) * 1024 + c]); }, b.mg, 1024, R, 1024, slots, k++);
    PH(8);
    nv::gemm(stream, b.mg, 1024, F(18), 1024, b.y, 1024, R, 1024, 1024);
    dbg::cmp(stream, [=] __device__(int r, int c) { return Y[(row0 + r) * 1024 + c]; }, b.y, 1024, R, 1024, slots, k++);
    PH(9);
    hipLaunchKernelGGL(nv::resid_norm, dim3(R), dim3(256), 0, stream, b.xo, b.y, F(19), 1.0f, b.xo);
    dbg::cmp(stream, [=] __device__(int r, int c) { return out[(row0 + r) * 1024 + c]; }, b.xo, 1024, R, 1024, slots, k++);
    hipLaunchKernelGGL(nv::rmsnorm, dim3(R), dim3(256), 0, stream, b.xo, 1024, F(20), b.h, 1024, 1024);
    dbg::cmp(stream, [=] __device__(int r, int c) { return b2f(HN[(row0 + r) * 1024 + c]); }, b.h, 1024, R, 1024, slots, k++);
    PH(10);
    nv::gemm(stream, b.h, 1024, F(21), 5632, b.big, 5632, R, 5632, 1024);
    hipLaunchKernelGGL(nv::swiglu, dim3((R * 2816 + 255) / 256), dim3(256), 0, stream, b.big, b.gg, R, 2816);
    dbg::cmp(stream, [=] __device__(int r, int c) { return b2f(Gb[(row0 + r) * 2816 + c]); }, b.gg, 2816, R, 2816, slots, k++);
    PH(11);
    nv::gemm(stream, b.gg, 2816, F(22), 1024, b.y, 1024, R, 1024, 2816);
    dbg::cmp(stream, [=] __device__(int r, int c) { return Y[(row0 + r) * 1024 + c]; }, b.y, 1024, R, 1024, slots, k++);
    PH(12);
    hipLaunchKernelGGL(dbg::report, dim3(1), dim3(64), 0, stream, slots, k, 2e-3f, out);
#endif
}
```

```cpp
#include <hip/hip_runtime.h>
#include <hip/hip_cooperative_groups.h>
#include <cstdio>
#include <cstdint>
#define MK_MODE 0
namespace pg8 {
#define PG8_LAS __attribute__((address_space(3)))
typedef unsigned short bf16_t;
typedef short bf16x8 __attribute__((ext_vector_type(8)));
typedef float f32x4 __attribute__((ext_vector_type(4)));
typedef unsigned u32x4 __attribute__((ext_vector_type(4)));
constexpr int BM = 256, BK = 64, HALF = 128, HTB = HALF * BK * 2  , STAGE_BYTES = 8 * HTB, NXCD = 8, WGM = 8;

__host__ __device__ __forceinline__ int lds_byte(int r, int c) { const int st = (r >> 4) * 2 + (c >> 5), rr = r & 15, cc = c & 31, ob = rr * 64 + cc * 2; return st * 1024 + (ob ^ (((ob >> 9) & 1) << 5)); }
__host__ __device__ __forceinline__ void stage_rc(int b, int& R, int& C) { const int st = b / 1024, sb = b % 1024, swz = sb ^ (((sb >> 9) & 1) << 5); R = (st >> 1) * 16 + swz / 64; C = (st & 1) * 32 + (swz % 64) / 2; }
__host__ __device__ __forceinline__ int perm32(int rho) { const int n = rho >> 4, i = rho & 15; return 8 * (i >> 2) + 4 * n + (i & 3); }

struct Unit { int pm, pn; };
struct Gemm { const bf16_t* A; const bf16_t* Bt; int M, N, K; };

struct StaticOrder {
    int nM, nN, nwg, G, c;
    __host__ __device__ void init(int M, int N, int G_, int c_) { nM = M / BM; nN = N / BM; nwg = nM * nN; G = G_; c = c_; }
    __host__ __device__ bool next(int i, Unit& u) const {
        const long L = (long)i * G + c; if (L >= nwg) return false;
        int wgid = (int)L; { const int q = nwg / NXCD, r = nwg % NXCD, xcd = wgid % NXCD, off = wgid / NXCD; wgid = (xcd < r ? xcd * (q + 1) : r * (q + 1) + (xcd - r) * q) + off; }
        const int nig = WGM * nN, gid = wgid / nig, fm = gid * WGM, gsz = (nM - fm) < WGM ? (nM - fm) : WGM;
        u.pm = fm + ((wgid % nig) % gsz); u.pn = (wgid % nig) / gsz; return true;
    }
    __device__ __forceinline__ void a_ready(const Unit&) const {}
    __device__ __forceinline__ void done(const Unit&) const {}
};


struct OffsetOrder {
    int nM, nN, nwg, G, c, base, limit;
    __host__ __device__ void init(int M, int N, int G_, int c_, int base_, int limit_) { nM = M / BM; nN = N / BM; nwg = nM * nN; G = G_; c = c_; base = base_; limit = limit_ < nwg ? limit_ : nwg; }
    __host__ __device__ bool next(int i, Unit& u) const {
        const long L = (long)base + (long)i * G + c; if (L >= limit) return false;
        int wgid = (int)L; { const int q = nwg / NXCD, r = nwg % NXCD, xcd = wgid % NXCD, off = wgid / NXCD; wgid = (xcd < r ? xcd * (q + 1) : r * (q + 1) + (xcd - r) * q) + off; }
        const int nig = WGM * nN, gid = wgid / nig, fm = gid * WGM, gsz = (nM - fm) < WGM ? (nM - fm) : WGM;
        u.pm = fm + ((wgid % nig) % gsz); u.pn = (wgid % nig) / gsz; return true;
    }
    __device__ __forceinline__ void a_ready(const Unit&) const {}
    __device__ __forceinline__ void done(const Unit&) const {}
};

template <class Epi, class Sched, bool ALIGN_EPI = false, bool SP2 = false>
__device__ __forceinline__ void gemm_phase(PG8_LAS unsigned char* lds, const Gemm g, const Sched& S, const Epi& E) {
    const int tid = threadIdx.x, wid = __builtin_amdgcn_readfirstlane(tid >> 6), lane = tid & 63, wr = wid >> 2, wc = wid & 3, fr = lane & 15, fq = lane >> 4;
    const int K = g.K, nt = K / BK;
    unsigned voffA[2], voffB[2];
#pragma unroll
    for (int i = 0; i < 2; ++i) { int R, C; stage_rc(tid * 16 + i * 8192, R, C); const int Rb = Epi::PERM ? ((R & ~31) + perm32(R & 31)) : R;
        voffA[i] = (unsigned)(R * K + C) * 2u; voffB[i] = (unsigned)(Rb * K + C) * 2u; }
    const size_t kstep = (size_t)(BK * 2);
    const size_t hstep = (size_t)HALF * K * 2;
    const size_t tstep = 2 * hstep;
    const unsigned ldsw = (unsigned)wid * 1024u;
    const int aoff = lds_byte(wr * 64 + fr, fq * 8), boff = lds_byte(wc * 32 + fr, fq * 8);
#define PG8_SA(b, h) (((b) * 2 + (h)) * HTB)
#define PG8_SB(b, h) ((4 + (b) * 2 + (h)) * HTB)
#define PG8_STAGE(bufoff, gbase, voff) do { _Pragma("unroll") for (int _i = 0; _i < 2; ++_i) \
        __builtin_amdgcn_global_load_lds((const unsigned*)((const char*)(gbase) + (voff)[_i]), (PG8_LAS unsigned*)(lds + (bufoff) + ldsw + _i * 8192), 16, 0, 0); } while (0)
#define PG8_LDA(dst, b, h) do { _Pragma("unroll") for (int m = 0; m < 4; ++m) _Pragma("unroll") for (int k = 0; k < 2; ++k) dst[m][k] = *(const PG8_LAS bf16x8*)(lds + PG8_SA(b, h) + aoff + m * 2048 + k * 1024); } while (0)
#define PG8_LDB(dst, b, h) do { _Pragma("unroll") for (int n = 0; n < 2; ++n) _Pragma("unroll") for (int k = 0; k < 2; ++k) dst[n][k] = *(const PG8_LAS bf16x8*)(lds + PG8_SB(b, h) + boff + n * 2048 + k * 1024); } while (0)
#define PG8_MMA(ai, bj, At, Bt) do { __builtin_amdgcn_s_setprio(1); _Pragma("unroll") for (int m = 0; m < 4; ++m) _Pragma("unroll") for (int n = 0; n < 2; ++n) _Pragma("unroll") for (int k = 0; k < 2; ++k) \
        acc[ai][bj][m][n] = __builtin_amdgcn_mfma_f32_16x16x32_bf16(Bt[n][k], At[m][k], acc[ai][bj][m][n], 0, 0, 0); __builtin_amdgcn_s_setprio(0); } while (0)
#define PG8_WAIT_V(n) asm volatile("s_waitcnt vmcnt(" #n ")" ::: "memory")
#define PG8_WAIT_L(n) asm volatile("s_waitcnt lgkmcnt(" #n ")" ::: "memory")
#define PG8_BAR __builtin_amdgcn_s_barrier()
#define PG8_SCHED __builtin_amdgcn_sched_barrier(0)
    Unit cur, nxt; int ui = 0;
    if (!S.next(0, cur)) return;
    f32x4 acc[2][2][4][2];
#pragma unroll
    for (int a = 0; a < 2; ++a)
#pragma unroll
        for (int b = 0; b < 2; ++b)
#pragma unroll
            for (int m = 0; m < 4; ++m)
#pragma unroll
                for (int n = 0; n < 2; ++n) acc[a][b][m][n] = (f32x4){0.f, 0.f, 0.f, 0.f};
    bf16x8 At[4][2], B0[2][2], B1[2][2];
    const char* cA = (const char*)g.A + (size_t)cur.pm * tstep; const char* cB = (const char*)g.Bt + (size_t)cur.pn * tstep;
    S.a_ready(cur);
    if constexpr (SP2) {
        PG8_STAGE(PG8_SB(0, 0), cB, voffB); PG8_STAGE(PG8_SB(0, 1), cB + hstep, voffB); PG8_STAGE(PG8_SA(0, 0), cA, voffA); PG8_STAGE(PG8_SA(0, 1), cA + hstep, voffA);
        if (wr == 1) PG8_BAR;
        PG8_WAIT_V(2); PG8_BAR;
        PG8_STAGE(PG8_SB(1, 0), cB + kstep, voffB); PG8_STAGE(PG8_SA(1, 0), cA + kstep, voffA); PG8_STAGE(PG8_SB(1, 1), cB + hstep + kstep, voffB);
        PG8_WAIT_V(6); PG8_BAR;
    } else {
        PG8_STAGE(PG8_SB(0, 0), cB, voffB); PG8_STAGE(PG8_SA(0, 0), cA, voffA); PG8_STAGE(PG8_SB(0, 1), cB + hstep, voffB); PG8_STAGE(PG8_SA(0, 1), cA + hstep, voffA);
        if (wr == 1) PG8_BAR;
        PG8_WAIT_V(4); PG8_BAR;
        PG8_STAGE(PG8_SB(1, 0), cB + kstep, voffB); PG8_STAGE(PG8_SA(1, 0), cA + kstep, voffA); PG8_STAGE(PG8_SB(1, 1), cB + hstep + kstep, voffB);
        PG8_WAIT_V(6); PG8_BAR;
    }
    for (;;) {
        const bool has_next = S.next(ui + 1, nxt);
        const char* nA = has_next ? (const char*)g.A + (size_t)nxt.pm * tstep : cA; const char* nB = has_next ? (const char*)g.Bt + (size_t)nxt.pn * tstep : cB;
        for (int t = 0; t < nt; t += 2) {
            const bool last = (t == nt - 2);
            if constexpr (Epi::KHOOK) { if (Epi::is_hook(t)) {
                if constexpr (ALIGN_EPI) { if (wr == 0) PG8_BAR; }
                E.khook(acc, cur, t, wr, wc, fr, fq);
                if constexpr (ALIGN_EPI) { if (wr == 1) PG8_BAR; } } }

            const char* a1 = cA + (size_t)(t + 1) * kstep;
            const char* a2 = last ? nA : cA + (size_t)(t + 2) * kstep; const char* b2 = last ? nB : cB + (size_t)(t + 2) * kstep;
            const char* a3 = a2 + kstep; const char* b3 = b2 + kstep;
            if (last && has_next) S.a_ready(nxt);
            if constexpr (SP2) {
            PG8_LDB(B0, 0, 0); PG8_LDB(B1, 0, 1); PG8_SCHED; PG8_LDA(At, 0, 0); PG8_STAGE(PG8_SA(1, 1), a1 + hstep, voffA);
            PG8_WAIT_V(8); PG8_WAIT_L(0); PG8_BAR; PG8_MMA(0, 0, At, B0); PG8_MMA(0, 1, At, B1); PG8_BAR; PG8_SCHED;
            PG8_LDA(At, 0, 1); PG8_STAGE(PG8_SB(0, 0), b2, voffB); PG8_STAGE(PG8_SB(0, 1), b2 + hstep, voffB); PG8_STAGE(PG8_SA(0, 0), a2, voffA);
            PG8_WAIT_V(8); PG8_WAIT_L(0); PG8_BAR; PG8_MMA(1, 0, At, B0); PG8_MMA(1, 1, At, B1); PG8_BAR; PG8_SCHED;
            PG8_LDB(B0, 1, 0); PG8_LDB(B1, 1, 1); PG8_SCHED; PG8_LDA(At, 1, 0); PG8_STAGE(PG8_SA(0, 1), a2 + hstep, voffA);
            PG8_WAIT_V(8); PG8_WAIT_L(0); PG8_BAR; PG8_MMA(0, 0, At, B0); PG8_MMA(0, 1, At, B1); PG8_BAR; PG8_SCHED;
            PG8_LDA(At, 1, 1); PG8_STAGE(PG8_SB(1, 0), b3, voffB); PG8_STAGE(PG8_SB(1, 1), b3 + hstep, voffB); PG8_STAGE(PG8_SA(1, 0), a3, voffA);
            PG8_WAIT_V(8); PG8_WAIT_L(0); PG8_BAR; PG8_MMA(1, 0, At, B0); PG8_MMA(1, 1, At, B1); PG8_BAR; PG8_SCHED;
            } else {
            PG8_LDB(B0, 0, 0); PG8_SCHED; PG8_LDA(At, 0, 0); PG8_STAGE(PG8_SA(1, 1), a1 + hstep, voffA);
            PG8_WAIT_L(8); PG8_BAR; PG8_WAIT_L(0); PG8_MMA(0, 0, At, B0); PG8_BAR; PG8_SCHED;
            PG8_LDB(B1, 0, 1); PG8_STAGE(PG8_SB(0, 0), b2, voffB);
            PG8_BAR; PG8_WAIT_L(0); PG8_MMA(0, 1, At, B1); PG8_BAR;
            PG8_LDA(At, 0, 1); PG8_STAGE(PG8_SA(0, 0), a2, voffA);
            PG8_BAR; PG8_WAIT_L(0); PG8_MMA(1, 0, At, B0); PG8_BAR; PG8_SCHED;
            PG8_STAGE(PG8_SB(0, 1), b2 + hstep, voffB);
            PG8_WAIT_V(6); PG8_BAR; PG8_MMA(1, 1, At, B1); PG8_BAR;
            PG8_LDB(B0, 1, 0); PG8_SCHED; PG8_LDA(At, 1, 0); PG8_STAGE(PG8_SA(0, 1), a2 + hstep, voffA);
            PG8_WAIT_L(8); PG8_BAR; PG8_WAIT_L(0); PG8_MMA(0, 0, At, B0); PG8_BAR; PG8_SCHED;
            PG8_LDB(B1, 1, 1); PG8_STAGE(PG8_SB(1, 0), b3, voffB);
            PG8_BAR; PG8_WAIT_L(0); PG8_MMA(0, 1, At, B1); PG8_BAR;
            PG8_LDA(At, 1, 1); PG8_STAGE(PG8_SA(1, 0), a3, voffA);
            PG8_BAR; PG8_WAIT_L(0); PG8_MMA(1, 0, At, B0); PG8_BAR; PG8_SCHED;
            PG8_STAGE(PG8_SB(1, 1), b3 + hstep, voffB);
            PG8_WAIT_V(6); PG8_BAR; PG8_MMA(1, 1, At, B1); PG8_BAR;
            }
        }
        if constexpr (ALIGN_EPI) { if (wr == 0) PG8_BAR; }
        asm volatile("s_nop 7\n\ts_nop 7\n\ts_nop 7" ::: "memory");
        if constexpr (!Epi::AFTER_DRAIN) { E(acc, cur, wr, wc, fr, fq); S.done(cur); }
        if (!has_next) break;
#pragma unroll
        for (int a = 0; a < 2; ++a)
#pragma unroll
            for (int b = 0; b < 2; ++b)
#pragma unroll
                for (int m = 0; m < 4; ++m)
#pragma unroll
                    for (int n = 0; n < 2; ++n) acc[a][b][m][n] = (f32x4){0.f, 0.f, 0.f, 0.f};
        cur = nxt; cA = nA; cB = nB; ++ui;
        if constexpr (ALIGN_EPI) { if (wr == 1) PG8_BAR; }
    }
    PG8_WAIT_V(0);
    if constexpr (!ALIGN_EPI) { if (wr == 0) PG8_BAR; }
    PG8_BAR;
    if constexpr (Epi::AFTER_DRAIN) { E.fused(acc, cur, wr, wc, fr, fq, lds, wid, lane); S.done(cur); }
#undef PG8_SA
#undef PG8_SB
#undef PG8_STAGE
#undef PG8_LDA
#undef PG8_LDB
#undef PG8_MMA
#undef PG8_WAIT_V
#undef PG8_WAIT_L
#undef PG8_BAR
#undef PG8_SCHED
}
}
namespace mk {
#define LAS __attribute__((address_space(3)))
typedef unsigned short bf16_t;
typedef short bf16x8 __attribute__((ext_vector_type(8)));
typedef short s16x4 __attribute__((ext_vector_type(4)));
typedef float f32x4 __attribute__((ext_vector_type(4)));
typedef float f32x16 __attribute__((ext_vector_type(16)));
typedef unsigned u32x4 __attribute__((ext_vector_type(4)));
typedef unsigned u32x2 __attribute__((ext_vector_type(2)));
using pg8::Unit;

constexpr int T = 32768, D = 1024, FF = 2816, NB = 8, SEQ = 4096;
constexpr float EPS = 1e-6f, LOG2E = 1.4426950408889634f, LN2 = 0.6931471805599453f;
constexpr float QSCALE = 0.08838834764831845f, XSCALE = 0.08838834764831845f * 1.4426950408889634f;
constexpr size_t MiB = 1u << 20;
constexpr size_t WS_CTL = 0, CTL_BYTES = 65536;
constexpr size_t WS_FLOW = 1 * MiB;
constexpr size_t WS_DEC = 2 * MiB;
constexpr size_t WS_OSS = 3 * MiB;
constexpr size_t WS_MEMN = 11 * MiB;
constexpr size_t WS_KM = 15 * MiB;
constexpr size_t WS_VMT = 17 * MiB;
constexpr size_t WS_WFU = 19 * MiB;
constexpr size_t WS_WF = 19 * MiB + 65536;
constexpr size_t WS_W1A = 20 * MiB, WS_W1B = 31 * MiB + 512 * 1024, WS_W2A = 37 * MiB + 512 * 1024, WS_W2B = 48 * MiB + 512 * 1024;
constexpr size_t WS_WIN = 54 * MiB + 512 * 1024, WS_WUP = 69 * MiB, WS_WO = 73 * MiB, WS_WMKV = 75 * MiB, WS_WPOOL = 77 * MiB;
constexpr size_t WS_HN = 78 * MiB;
constexpr size_t WS_M = 142 * MiB;
constexpr size_t WS_Q = WS_M, WS_KT = WS_M + 32 * MiB, WS_VT = WS_M + 64 * MiB, WS_PIN = WS_M + 128 * MiB, WS_XQ = WS_M + 160 * MiB;
constexpr size_t WS_A2 = 334 * MiB;
constexpr size_t WS_GC = 462 * MiB;
constexpr size_t WS_END = 494 * MiB;
static_assert(WS_W1A + (size_t)5632 * 1024 * 2 <= WS_W1B && WS_W1B + (size_t)1024 * 2816 * 2 <= WS_W2A && WS_W2A + (size_t)5632 * 1024 * 2 <= WS_W2B &&
              WS_W2B + (size_t)1024 * 2816 * 2 <= WS_WIN && WS_WIN + (size_t)7168 * 1024 * 2 <= WS_WUP && WS_WUP + (size_t)1024 * 2048 * 2 <= WS_WO && WS_WPOOL + 131072 <= WS_HN, "ws map");

constexpr int LDS_BYTES = 163840;
constexpr int LDSCTL_OFF = 131072;
constexpr int CW_BAR = 4096;
constexpr int NTHREADS = 512;
constexpr int P5_GATE_UNITS = 4;

__device__ __forceinline__ unsigned cvt_pk_bf16(float lo, float hi) { unsigned r; asm volatile("s_nop 0\n\tv_cvt_pk_bf16_f32 %0, %1, %2" : "=v"(r) : "v"(lo), "v"(hi)); return r; }
typedef __bf16 bf16x2_t __attribute__((ext_vector_type(2)));
typedef float f32x2_t __attribute__((ext_vector_type(2)));
__device__ __forceinline__ unsigned cvt_pk_bf16_c(float lo, float hi) { const f32x2_t v = {lo, hi}; return __builtin_bit_cast(unsigned, __builtin_convertvector(v, bf16x2_t)); }
__device__ __forceinline__ float bflo(unsigned w) { return __uint_as_float(w << 16); }
__device__ __forceinline__ float bfhi(unsigned w) { return __uint_as_float(w & 0xffff0000u); }
__device__ __forceinline__ float ex2(float x) { return __builtin_amdgcn_exp2f(x); }
__device__ __forceinline__ float rcp(float x) { return __builtin_amdgcn_rcpf(x); }
__device__ __forceinline__ float silu(float a) { return a * rcp(1.f + ex2(-a * LOG2E)); }
__device__ __forceinline__ float sigm(float a) { return rcp(1.f + ex2(-a * LOG2E)); }
__device__ __forceinline__ float add_xor16(float x) { const unsigned u = __float_as_uint(x); const auto r = __builtin_amdgcn_permlane16_swap(u, u, false, false); return __uint_as_float(r[0]) + __uint_as_float(r[1]); }
__device__ __forceinline__ float add_xor32(float x) { const unsigned u = __float_as_uint(x); const auto r = __builtin_amdgcn_permlane32_swap(u, u, false, false); return __uint_as_float(r[0]) + __uint_as_float(r[1]); }
__device__ __forceinline__ float wave_sum(float v) {
#pragma unroll
    for (int o = 1; o < 64; o <<= 1) v += __shfl_xor(v, o);
    return v;
}
__device__ __forceinline__ bf16x8 ld16(const bf16_t* p) { return *(const bf16x8*)p; }
__device__ __forceinline__ bf16x8 cat8(s16x4 a, s16x4 b) { return __builtin_shufflevector(a, b, 0, 1, 2, 3, 4, 5, 6, 7); }
__device__ __forceinline__ bf16x8 as_bf16x8(u32x4 w) { return __builtin_bit_cast(bf16x8, w); }
__device__ __forceinline__ f32x4 mfma16(bf16x8 a, bf16x8 b, f32x4 c) { return __builtin_amdgcn_mfma_f32_16x16x32_bf16(a, b, c, 0, 0, 0); }
__device__ __forceinline__ f32x16 mfma32(bf16x8 a, bf16x8 b, f32x16 c) { return __builtin_amdgcn_mfma_f32_32x32x16_bf16(a, b, c, 0, 0, 0); }
template <int N> __device__ __forceinline__ float row_shr(float x) {
    return __int_as_float(__builtin_amdgcn_update_dpp(0, __float_as_int(x), 0x110 + N, 0xf, 0xf, true));
}

typedef f32x4 Acc[2][2][4][2];

struct EpiYbf {
    static constexpr bool PERM = true, AFTER_DRAIN = false, KHOOK = false; static constexpr int KH0 = -1, KH1 = -1;
    bf16_t* Yb;
    __device__ __forceinline__ void operator()(Acc& acc, const Unit& u, int wr, int wc, int fr, int fq) const {
        const int row0 = u.pm * 256 + wr * 64 + fr, col0 = u.pn * 256 + wc * 32 + 8 * fq;
#pragma unroll
        for (int ai = 0; ai < 2; ++ai)
#pragma unroll
            for (int m = 0; m < 4; ++m)
#pragma unroll
                for (int bj = 0; bj < 2; ++bj) { const f32x4 a0 = acc[ai][bj][m][0], a1 = acc[ai][bj][m][1];
                    u32x4 w; w.x = cvt_pk_bf16(a0[0], a0[1]); w.y = cvt_pk_bf16(a0[2], a0[3]); w.z = cvt_pk_bf16(a1[0], a1[1]); w.w = cvt_pk_bf16(a1[2], a1[3]);
                    *(u32x4*)(Yb + (size_t)(row0 + ai * 128 + m * 16) * 1024 + col0 + bj * 128) = w; }
    }
};
struct EpiSwiglu {
    static constexpr bool PERM = true, AFTER_DRAIN = false, KHOOK = false; static constexpr int KH0 = -1, KH1 = -1;
    bf16_t* G;
    __device__ __forceinline__ void operator()(Acc& acc, const Unit& u, int wr, int wc, int fr, int fq) const {
        const int row0 = u.pm * 256 + wr * 64 + fr, col0 = u.pn * 128 + wc * 32 + 8 * fq;
#pragma unroll
        for (int ai = 0; ai < 2; ++ai)
#pragma unroll
            for (int m = 0; m < 4; ++m) {
                const f32x4 a0 = acc[ai][0][m][0], a1 = acc[ai][0][m][1], b0 = acc[ai][1][m][0], b1 = acc[ai][1][m][1];
                u32x4 w;
                w.x = cvt_pk_bf16(a0[0] * b0[0] * rcp(1.f + ex2(a0[0])), a0[1] * b0[1] * rcp(1.f + ex2(a0[1]))); w.y = cvt_pk_bf16(a0[2] * b0[2] * rcp(1.f + ex2(a0[2])), a0[3] * b0[3] * rcp(1.f + ex2(a0[3])));
                w.z = cvt_pk_bf16(a1[0] * b1[0] * rcp(1.f + ex2(a1[0])), a1[1] * b1[1] * rcp(1.f + ex2(a1[1]))); w.w = cvt_pk_bf16(a1[2] * b1[2] * rcp(1.f + ex2(a1[2])), a1[3] * b1[3] * rcp(1.f + ex2(a1[3])));
                *(u32x4*)(G + (size_t)(row0 + ai * 128 + m * 16) * FF + col0) = w;
            }
    }
};
struct EpiGates {
    static constexpr bool PERM = true, AFTER_DRAIN = false, KHOOK = false; static constexpr int KH0 = -1, KH1 = -1;
    unsigned char *GA, *GC;
    __device__ __forceinline__ void operator()(Acc& acc, const Unit& u, int wr, int wc, int fr, int fq) const {
        const int gsel = u.pn >> 2;
        unsigned char* gb = (gsel < 2 ? GA + (size_t)gsel * (32u << 20) : GC) + (size_t)(u.pm * 4 + (u.pn & 3)) * 65536u + threadIdx.x * 16u;
#pragma unroll
        for (int ai = 0; ai < 2; ++ai)
#pragma unroll
            for (int m = 0; m < 4; ++m) {
                u32x4 w = {0u, 0u, 0u, 0u};
#pragma unroll
                for (int bj = 0; bj < 2; ++bj) {
                    const f32x4 a0 = acc[ai][bj][m][0], a1 = acc[ai][bj][m][1];
                    unsigned w0 = 0u, w1 = 0u;
#pragma unroll
                    for (int j = 0; j < 4; ++j) {
                        w0 = __builtin_amdgcn_cvt_pk_u8_f32(rintf(32.f * __log2f(1.f + ex2(a0[j]))), j, w0);
                        w1 = __builtin_amdgcn_cvt_pk_u8_f32(rintf(32.f * __log2f(1.f + ex2(a1[j]))), j, w1); }
                    if (bj == 0) { w.x = w0; w.y = w1; } else { w.z = w0; w.w = w1; }
                }
                *(u32x4*)(gb + (unsigned)((ai * 4 + m) * 8192)) = w;
            }
    }
};
struct EpiMerge {
    static constexpr bool PERM = true, AFTER_DRAIN = false, KHOOK = true; static constexpr int KH0 = 16, KH1 = 24;
    static __device__ __forceinline__ bool is_hook(int t) { return t == 4 || t == 8 || t == 12 || t == 16 || t == 24; }
    const unsigned char *GA, *GC; bf16_t* MG; const float* RR;
    __device__ __forceinline__ void khook(Acc& acc, const Unit& u, int t, int wr, int wc, int fr, int fq) const {
        int ofr = fr, ofq = fq; asm volatile("" : "+v"(ofr), "+v"(ofq));
        {
            const unsigned rbase = ((unsigned)(u.pm * 256 + wr * 64 + ofr) * 4u + (unsigned)(t >= 16 ? 3 : (t >> 2) - 1)) * 4u;
            if (t != 24) {
                const char* rb = (const char*)RR;
                float f[2][4];
#pragma unroll
                for (int ai = 0; ai < 2; ++ai)
#pragma unroll
                    for (int m = 0; m < 4; ++m) f[ai][m] = *(const float*)(rb + rbase + (unsigned)((ai * 128 + m * 16) * 16));
#pragma unroll
                for (int ai = 0; ai < 2; ++ai)
#pragma unroll
                    for (int m = 0; m < 4; ++m)
#pragma unroll
                        for (int bj = 0; bj < 2; ++bj) { acc[ai][bj][m][0] *= f[ai][m]; acc[ai][bj][m][1] *= f[ai][m]; }
                asm volatile("" ::: "memory");
            }
            if (t < 16) return;
        }
        int otid = threadIdx.x; asm volatile("" : "+v"(otid));
        const size_t uo = (size_t)(u.pm * 4 + u.pn) * 65536u + (unsigned)otid * 16u;
        const unsigned char* gb = GA + (t == 16 ? (size_t)0 : (size_t)(32u << 20)) + uo;
        const unsigned char* gn = t == 16 ? GA + (size_t)(32u << 20) + uo : GC + uo;
#pragma unroll
        for (int ai = 0; ai < 2; ++ai) {
            u32x4 qpv[4], qnv[4];
#pragma unroll
            for (int m = 0; m < 4; ++m) { const unsigned o = (unsigned)((ai * 4 + m) * 8192); qpv[m] = *(const u32x4*)(gb + o); qnv[m] = *(const u32x4*)(gn + o); }
#pragma unroll
            for (int m = 0; m < 4; ++m) {
                const u32x4 qp4 = qpv[m], qn4 = qnv[m];
#pragma unroll
                for (int bj = 0; bj < 2; ++bj) {
                    const u32x2 qp = bj == 0 ? (u32x2){qp4.x, qp4.y} : (u32x2){qp4.z, qp4.w}, qn = bj == 0 ? (u32x2){qn4.x, qn4.y} : (u32x2){qn4.z, qn4.w};
                    f32x4& a0 = acc[ai][bj][m][0]; f32x4& a1 = acc[ai][bj][m][1];
                    a0[0] *= ex2(((float)((qn.x) & 255u) - (float)((qp.x) & 255u)) * 0.03125f);             a0[1] *= ex2(((float)((qn.x >> 8) & 255u) - (float)((qp.x >> 8) & 255u)) * 0.03125f);
                    a0[2] *= ex2(((float)((qn.x >> 16) & 255u) - (float)((qp.x >> 16) & 255u)) * 0.03125f); a0[3] *= ex2(((float)(qn.x >> 24) - (float)(qp.x >> 24)) * 0.03125f);
                    a1[0] *= ex2(((float)((qn.y) & 255u) - (float)((qp.y) & 255u)) * 0.03125f);             a1[1] *= ex2(((float)((qn.y >> 8) & 255u) - (float)((qp.y >> 8) & 255u)) * 0.03125f);
                    a1[2] *= ex2(((float)((qn.y >> 16) & 255u) - (float)((qp.y >> 16) & 255u)) * 0.03125f); a1[3] *= ex2(((float)(qn.y >> 24) - (float)(qp.y >> 24)) * 0.03125f); } }
            asm volatile("" ::: "memory"); }
    }
    __device__ __forceinline__ void operator()(Acc& acc, const Unit& u, int wr, int wc, int fr, int fq) const {
        int ofr = fr, ofq = fq; asm volatile("" : "+v"(ofr), "+v"(ofq));
        const unsigned r0 = (unsigned)(u.pm * 256 + wr * 64 + ofr), c0 = (unsigned)(u.pn * 256 + wc * 32 + 8 * ofq);
        const unsigned char* gb = GC + (size_t)(u.pm * 4 + u.pn) * 65536u + threadIdx.x * 16u; char* mb = (char*)MG;
#pragma unroll
        for (int ai = 0; ai < 2; ++ai) {
            u32x4 qcv[4];
#pragma unroll
            for (int m = 0; m < 4; ++m) qcv[m] = *(const u32x4*)(gb + (unsigned)((ai * 4 + m) * 8192));
#pragma unroll
            for (int m = 0; m < 4; ++m) {
                const u32x4 qc4 = qcv[m];
#pragma unroll
                for (int bj = 0; bj < 2; ++bj) {
                    const unsigned r = r0 + (unsigned)(ai * 128 + m * 16), cc = c0 + (unsigned)(bj * 128);
                    const u32x2 qc = bj == 0 ? (u32x2){qc4.x, qc4.y} : (u32x2){qc4.z, qc4.w};
                    const f32x4 a0 = acc[ai][bj][m][0], a1 = acc[ai][bj][m][1];
                    u32x4 w;
                    w.x = cvt_pk_bf16(a0[0] * ex2((float)(qc.x & 255u) * -0.03125f), a0[1] * ex2((float)((qc.x >> 8) & 255u) * -0.03125f));
                    w.y = cvt_pk_bf16(a0[2] * ex2((float)((qc.x >> 16) & 255u) * -0.03125f), a0[3] * ex2((float)(qc.x >> 24) * -0.03125f));
                    w.z = cvt_pk_bf16(a1[0] * ex2((float)(qc.y & 255u) * -0.03125f), a1[1] * ex2((float)((qc.y >> 8) & 255u) * -0.03125f));
                    w.w = cvt_pk_bf16(a1[2] * ex2((float)((qc.y >> 16) & 255u) * -0.03125f), a1[3] * ex2((float)(qc.y >> 24) * -0.03125f));
                    *(u32x4*)(mb + (r * 1024u + cc) * 2u) = w;
                    asm volatile("" ::: "memory"); } } }
    }
};
struct EpiInProj {
    static constexpr bool PERM = true, AFTER_DRAIN = false, KHOOK = false; static constexpr int KH0 = -1, KH1 = -1;
    bf16_t *Q, *KT, *VT, *A2, *PIN, *XQ; float* DEC; const bf16_t *FLOW, *WFU; const float* b_f;
    template <bool SILU> __device__ __forceinline__ void plain(Acc& acc, const Unit& u, int wr, int wc, int fr, int fq, bf16_t* dst, int ld, int colbase, float sc) const {
        const int row0 = u.pm * 256 + wr * 64 + fr, col0 = colbase + wc * 32 + 8 * fq;
#pragma unroll
        for (int ai = 0; ai < 2; ++ai)
#pragma unroll
            for (int m = 0; m < 4; ++m)
#pragma unroll
                for (int bj = 0; bj < 2; ++bj) {
                    const f32x4 a0 = acc[ai][bj][m][0], a1 = acc[ai][bj][m][1];
                    float v[8];
#pragma unroll
                    for (int j = 0; j < 4; ++j) { v[j] = SILU ? silu(a0[j]) : a0[j] * sc; v[4 + j] = SILU ? silu(a1[j]) : a1[j] * sc; }
                    u32x4 w; w.x = cvt_pk_bf16(v[0], v[1]); w.y = cvt_pk_bf16(v[2], v[3]); w.z = cvt_pk_bf16(v[4], v[5]); w.w = cvt_pk_bf16(v[6], v[7]);
                    *(u32x4*)(dst + (size_t)(row0 + ai * 128 + m * 16) * ld + col0 + bj * 128) = w;
                }
    }
    __device__ __forceinline__ void vtile(Acc& acc, const Unit& u, int wr, int wc, int fr, int fq) const {
        const int h = u.pn - 4;
#pragma unroll
        for (int ai = 0; ai < 2; ++ai) {
            const int t0 = u.pm * 256 + ai * 128 + wr * 64, b = t0 >> 12, c = (t0 >> 6) & 63;
            bf16_t* base = VT + (size_t)((b * 4 + h) * 64 + c) * 256 * 64;
#pragma unroll
            for (int m = 0; m < 4; ++m) { const int s = 16 * m + fr;
#pragma unroll
                for (int bj = 0; bj < 2; ++bj)
#pragma unroll
                    for (int n = 0; n < 2; ++n) { const int vv = bj * 128 + wc * 32 + 8 * fq + 4 * n; const f32x4 a = acc[ai][bj][m][n];
                        const unsigned w0 = cvt_pk_bf16(a[0], a[1]), w1 = cvt_pk_bf16(a[2], a[3]);
                        base[(vv + 0) * 64 + s] = (bf16_t)(w0 & 0xffffu); base[(vv + 1) * 64 + s] = (bf16_t)(w0 >> 16);
                        base[(vv + 2) * 64 + s] = (bf16_t)(w1 & 0xffffu); base[(vv + 3) * 64 + s] = (bf16_t)(w1 >> 16); } }
        }
    }
    __device__ __forceinline__ void ktile(Acc& acc, const Unit& u, int wr, int wc, int fr, int fq) const {
        const int lane = threadIdx.x & 63;
        const bf16x8 zero8 = (bf16x8){0, 0, 0, 0, 0, 0, 0, 0};
#pragma unroll
        for (int ai = 0; ai < 2; ++ai) {
            const int t0 = u.pm * 256 + ai * 128 + wr * 64, b = t0 >> 12, c = (t0 >> 6) & 63;
            bf16x8 ff[4];
#pragma unroll
            for (int m = 0; m < 4; ++m) ff[m] = (fq < 2) ? ld16(FLOW + (size_t)(t0 + 16 * m + fr) * 16 + 8 * fq) : zero8;
#pragma unroll
            for (int bj = 0; bj < 2; ++bj) {
                const int h = (u.pn - 2) * 2 + bj;
                bf16_t* ktb = KT + (size_t)((b * 4 + h) * 64 + c) * 128 * 64;
#pragma unroll
                for (int n = 0; n < 2; ++n) {
                    const int cw = h * 128 + wc * 32 + 8 * (fr >> 2) + 4 * n + (fr & 3);
                    const bf16x8 wf = (fq < 2) ? ld16(WFU + (size_t)cw * 16 + 8 * fq) : zero8;
                    const int kk = wc * 32 + 8 * fq + 4 * n;
                    const f32x4 bias = *(const f32x4*)(b_f + h * 128 + kk) * LOG2E;
                    f32x4 la[4];
#pragma unroll
                    for (int m = 0; m < 4; ++m) { f32x4 f = mfma16(wf, ff[m], (f32x4){0.f, 0.f, 0.f, 0.f});
#pragma unroll
                        for (int j = 0; j < 4; ++j) { const float x = f[j] + bias[j]; const float e = ex2(-fabsf(x));
                            la[m][j] = (fminf(x, 0.f) - __log2f(1.f + e)) * (1.f / 16.f); } }
                    f32x4 run = (f32x4){0.f, 0.f, 0.f, 0.f};
#pragma unroll
                    for (int m = 0; m < 4; ++m)
#pragma unroll
                        for (int j = 0; j < 4; ++j) { float x = la[m][j];
                            x += row_shr<1>(x); x += row_shr<2>(x); x += row_shr<4>(x); x += row_shr<8>(x);
                            const float tot = __int_as_float(__builtin_amdgcn_update_dpp(0, __float_as_int(x), 0x15F, 0xf, 0xf, false));
                            la[m][j] = x + run[j]; run[j] += tot; }
#pragma unroll
                    for (int m = 0; m < 4; ++m) { const int s = 16 * m + fr; const f32x4 a = acc[ai][bj][m][n];
                        const unsigned w0 = cvt_pk_bf16(a[0] * ex2(run[0] - la[m][0]), a[1] * ex2(run[1] - la[m][1]));
                        const unsigned w1 = cvt_pk_bf16(a[2] * ex2(run[2] - la[m][2]), a[3] * ex2(run[3] - la[m][3]));
                        ktb[(kk + 0) * 64 + s] = (bf16_t)(w0 & 0xffffu); ktb[(kk + 1) * 64 + s] = (bf16_t)(w0 >> 16);
                        ktb[(kk + 2) * 64 + s] = (bf16_t)(w1 & 0xffffu); ktb[(kk + 3) * 64 + s] = (bf16_t)(w1 >> 16); }
                    if (fr == 0) *(f32x4*)(DEC + (size_t)(b * 64 + c) * 512 + h * 128 + kk) = (f32x4){ex2(run[0]), ex2(run[1]), ex2(run[2]), ex2(run[3])};
                }
            }
        }
    }
    __device__ __forceinline__ void operator()(Acc& acc, const Unit& u, int wr, int wc, int fr, int fq) const {
        const int pn = u.pn;
        if (pn < 2) plain<false>(acc, u, wr, wc, fr, fq, Q, 512, pn * 256, QSCALE);
        else if (pn < 4) ktile(acc, u, wr, wc, fr, fq);
        else if (pn < 8) vtile(acc, u, wr, wc, fr, fq);
        else if (pn < 12) plain<true>(acc, u, wr, wc, fr, fq, A2, 2048, (pn - 8) * 256, 1.f);
        else if (pn < 14) plain<false>(acc, u, wr, wc, fr, fq, PIN, 512, (pn - 12) * 256, 1.f);
        else plain<false>(acc, u, wr, wc, fr, fq, XQ, 512, (pn - 14) * 256, XSCALE);
    }
};

struct Row { f32x4 v[4]; };
__device__ __forceinline__ Row ld_row(const float* p, int lane) { Row r; const float* q = p + 8 * lane;
    r.v[0] = *(const f32x4*)q; r.v[1] = *(const f32x4*)(q + 4); r.v[2] = *(const f32x4*)(q + 512); r.v[3] = *(const f32x4*)(q + 516); return r; }
__device__ __forceinline__ Row ld_row_nt(const float* p, int lane) { Row r; const f32x4* q = (const f32x4*)(p + 8 * lane);
    r.v[0] = __builtin_nontemporal_load(q); r.v[1] = __builtin_nontemporal_load(q + 1); r.v[2] = __builtin_nontemporal_load(q + 128); r.v[3] = __builtin_nontemporal_load(q + 129); return r; }
__device__ __forceinline__ void st_row(float* p, int lane, const Row& r) { float* q = p + 8 * lane;
    *(f32x4*)q = r.v[0]; *(f32x4*)(q + 4) = r.v[1]; *(f32x4*)(q + 512) = r.v[2]; *(f32x4*)(q + 516) = r.v[3]; }
__device__ __forceinline__ void st_row_nt(float* p, int lane, const Row& r) { f32x4* q = (f32x4*)(p + 8 * lane);
    __builtin_nontemporal_store(r.v[0], q); __builtin_nontemporal_store(r.v[1], q + 1); __builtin_nontemporal_store(r.v[2], q + 128); __builtin_nontemporal_store(r.v[3], q + 129); }
__device__ __forceinline__ Row ld_row_bf(const bf16_t* p, int lane) { Row r; const u32x4 a = __builtin_nontemporal_load((const u32x4*)(p + 8 * lane)), b = __builtin_nontemporal_load((const u32x4*)(p + 512 + 8 * lane));
    r.v[0] = (f32x4){bflo(a.x), bfhi(a.x), bflo(a.y), bfhi(a.y)}; r.v[1] = (f32x4){bflo(a.z), bfhi(a.z), bflo(a.w), bfhi(a.w)};
    r.v[2] = (f32x4){bflo(b.x), bfhi(b.x), bflo(b.y), bfhi(b.y)}; r.v[3] = (f32x4){bflo(b.z), bfhi(b.z), bflo(b.w), bfhi(b.w)}; return r; }
__device__ __forceinline__ float row_ss(const Row& r) { float s = 0.f;
#pragma unroll
    for (int j = 0; j < 4; ++j) s += (r.v[j][0] * r.v[j][0] + r.v[j][1] * r.v[j][1]) + (r.v[j][2] * r.v[j][2] + r.v[j][3] * r.v[j][3]);
    return wave_sum(s); }
__device__ __forceinline__ float rs_of(float ss) { return rsqrtf(ss * (1.f / 1024.f) + EPS); }
__device__ __forceinline__ Row mul_g(const Row& x, float rs, const Row& g) { Row r;
#pragma unroll
    for (int j = 0; j < 4; ++j) r.v[j] = x.v[j] * rs * g.v[j];
    return r; }
__device__ __forceinline__ void st_row_bf(const Row& h, bf16_t* out, int lane, LAS unsigned char* ldsrow) {
    u32x4 a, b; a.x = cvt_pk_bf16(h.v[0][0], h.v[0][1]); a.y = cvt_pk_bf16(h.v[0][2], h.v[0][3]); a.z = cvt_pk_bf16(h.v[1][0], h.v[1][1]); a.w = cvt_pk_bf16(h.v[1][2], h.v[1][3]);
    b.x = cvt_pk_bf16(h.v[2][0], h.v[2][1]); b.y = cvt_pk_bf16(h.v[2][2], h.v[2][3]); b.z = cvt_pk_bf16(h.v[3][0], h.v[3][1]); b.w = cvt_pk_bf16(h.v[3][2], h.v[3][3]);
    *(u32x4*)(out + 8 * lane) = a; *(u32x4*)(out + 512 + 8 * lane) = b;
    if (ldsrow) { *(LAS u32x4*)(ldsrow + 16 * lane) = a; *(LAS u32x4*)(ldsrow + 1024 + 16 * lane) = b; }
}

__device__ __forceinline__ void st_row_bf_nt(const Row& h, bf16_t* out, int lane) {
    u32x4 a, b; a.x = cvt_pk_bf16(h.v[0][0], h.v[0][1]); a.y = cvt_pk_bf16(h.v[0][2], h.v[0][3]); a.z = cvt_pk_bf16(h.v[1][0], h.v[1][1]); a.w = cvt_pk_bf16(h.v[1][2], h.v[1][3]);
    b.x = cvt_pk_bf16(h.v[2][0], h.v[2][1]); b.y = cvt_pk_bf16(h.v[2][2], h.v[2][3]); b.z = cvt_pk_bf16(h.v[3][0], h.v[3][1]); b.w = cvt_pk_bf16(h.v[3][2], h.v[3][3]);
    __builtin_nontemporal_store(a, (u32x4*)(out + 8 * lane)); __builtin_nontemporal_store(b, (u32x4*)(out + 512 + 8 * lane));
}

__device__ __forceinline__ unsigned pk2(float lo, float hi) { return cvt_pk_bf16(lo, hi); }
__device__ __forceinline__ void transpose_item(const float* W, int ldw, int k0, int ns0, bf16_t* WT, int ldt, int dr0, int dk0, LAS float* scr, int lane, float wscale = 1.f) {
    f32x4 v[8];
#pragma unroll
    for (int i = 0; i < 8; ++i) { const int kk = (lane >> 3) + 8 * i; v[i] = *(const f32x4*)(W + (size_t)(k0 + kk) * ldw + ns0 + 4 * (lane & 7)); }
#pragma unroll
    for (int i = 0; i < 8; ++i) { const int kk = (lane >> 3) + 8 * i; LAS float* q = scr + kk * 33 + 4 * (lane & 7); q[0] = v[i][0]; q[1] = v[i][1]; q[2] = v[i][2]; q[3] = v[i][3]; }
    asm volatile("s_waitcnt lgkmcnt(0)" ::: "memory");
    const int c = lane & 7;
#pragma unroll
    for (int j = 0; j < 4; ++j) { const int n = (lane >> 3) + 8 * j; const LAS float* s = scr + (8 * c) * 33 + n;
        u32x4 o; o.x = pk2(s[0 * 33] * wscale, s[1 * 33] * wscale); o.y = pk2(s[2 * 33] * wscale, s[3 * 33] * wscale); o.z = pk2(s[4 * 33] * wscale, s[5 * 33] * wscale); o.w = pk2(s[6 * 33] * wscale, s[7 * 33] * wscale);
        *(u32x4*)(WT + (size_t)(dr0 + n) * ldt + dk0 + 8 * c) = o; }
    asm volatile("s_waitcnt lgkmcnt(0)" ::: "memory");
}

struct Ptrs {
    const float* in[25]; float* out; unsigned char* ws; int ph_lo, ph_hi;
};
enum { I_X = 0, I_MEM, I_F1G, I_F1WI, I_F1WO, I_F1PG, I_MIXG, I_WIN, I_WFU, I_BF, I_GLAG, I_WPOOL, I_PSCALE, I_MEMG, I_WMKV, I_WUPG, I_WUPP, I_WUPX, I_WO, I_MIXPG, I_F2G, I_F2WI, I_F2WO, I_F2PG, I_FING };

__device__ __forceinline__ void p0_prologue(const Ptrs& P, LAS unsigned char* lds, int wave, int lane) {
    unsigned char* ws = P.ws;
    LAS float* scr = (LAS float*)(lds + wave * 16384);
    const int gw = blockIdx.x * 8 + wave, NGW = gridDim.x * 8;
    constexpr int I_FA = 16 * 176, I_FB = 44 * 32, I_IN = 16 * 224, I_UG = 16 * 32, I_UP = 8 * 32, I_SQ = 16 * 32, I_PL = 32;
    constexpr int NITEMS = 2 * (I_FA + I_FB) + I_IN + I_UG + 2 * I_UP + 2 * I_SQ + I_PL;
    for (int it = gw; it < NITEMS; it += NGW) {
        int r = it;
#pragma unroll
        for (int f = 0; f < 2; ++f) {
            if (r >= 0 && r < I_FA) { const int kb = r / 176, nb = r % 176, c = 32 * nb; const int dr = c < FF ? 256 * (c / 128) + (c % 128) : 256 * ((c - FF) / 128) + 128 + ((c - FF) % 128);
                transpose_item(P.in[f ? I_F2WI : I_F1WI], 2 * FF, 64 * kb, c, (bf16_t*)(ws + (f ? WS_W2A : WS_W1A)), 1024, dr, 64 * kb, scr, lane, c < FF ? -LOG2E : -LN2); r = -1; }
            if (r >= 0) r -= I_FA;
            if (r >= 0 && r < I_FB) { const int kb = r / 32, nb = r % 32;
                transpose_item(P.in[f ? I_F2WO : I_F1WO], 1024, 64 * kb, 32 * nb, (bf16_t*)(ws + (f ? WS_W2B : WS_W1B)), FF, 32 * nb, 64 * kb, scr, lane); r = -1; }
            if (r >= 0) r -= I_FB;
        }
        if (r < 0) continue;
        if (r < I_IN) { const int kb = r / 224, nb = r % 224, dr = 32 * nb, sc = dr < 3072 ? dr : dr + 16;
            transpose_item(P.in[I_WIN], 7184, 64 * kb, sc, (bf16_t*)(ws + WS_WIN), 1024, dr, 64 * kb, scr, lane, dr >= 4096 ? -LOG2E : 1.f); continue; } r -= I_IN;
        if (r < I_UG) { const int kb = r / 32, nb = r % 32; transpose_item(P.in[I_WUPG], 1024, 64 * kb, 32 * nb, (bf16_t*)(ws + WS_WUP), 2048, 32 * nb, 64 * kb, scr, lane); continue; } r -= I_UG;
        if (r < I_UP) { const int kb = r / 32, nb = r % 32; transpose_item(P.in[I_WUPP], 1024, 64 * kb, 32 * nb, (bf16_t*)(ws + WS_WUP), 2048, 32 * nb, 1024 + 64 * kb, scr, lane); continue; } r -= I_UP;
        if (r < I_UP) { const int kb = r / 32, nb = r % 32; transpose_item(P.in[I_WUPX], 1024, 64 * kb, 32 * nb, (bf16_t*)(ws + WS_WUP), 2048, 32 * nb, 1536 + 64 * kb, scr, lane); continue; } r -= I_UP;
        if (r < I_SQ) { const int kb = r / 32, nb = r % 32; transpose_item(P.in[I_WO], 1024, 64 * kb, 32 * nb, (bf16_t*)(ws + WS_WO), 1024, 32 * nb, 64 * kb, scr, lane); continue; } r -= I_SQ;
        if (r < I_SQ) { const int kb = r / 32, nb = r % 32; transpose_item(P.in[I_WMKV], 1024, 64 * kb, 32 * nb, (bf16_t*)(ws + WS_WMKV), 1024, 32 * nb, 64 * kb, scr, lane); continue; } r -= I_SQ;
        { const int g = r / 8, q = r % 8, kb = q / 4, nb = q % 4;
          transpose_item(P.in[I_WPOOL] + g * 16384, 128, 64 * kb, 32 * nb, (bf16_t*)(ws + WS_WPOOL) + g * 16384, 128, 32 * nb, 64 * kb, scr, lane); }
    }
    { const int gt = blockIdx.x * NTHREADS + threadIdx.x, NT = gridDim.x * NTHREADS;
      bf16_t* WF = (bf16_t*)(ws + WS_WF); bf16_t* WFU = (bf16_t*)(ws + WS_WFU);
      for (int i = gt; i < 16384; i += NT) { const int n = i >> 10, k = i & 1023; WF[i] = (bf16_t)(cvt_pk_bf16(P.in[I_WIN][(size_t)k * 7184 + 3072 + n], 0.f) & 0xffffu); }
      for (int i = gt; i < 8192; i += NT) { const int c = i >> 4, r = i & 15; WFU[i] = (bf16_t)(cvt_pk_bf16(P.in[I_WFU][r * 512 + c] * LOG2E, 0.f) & 0xffffu); } }
    bf16_t* HN = (bf16_t*)(ws + WS_HN); bf16_t* MEMN = (bf16_t*)(ws + WS_MEMN);
    for (int m = gw; m < T + 2048; m += NGW) {
        if (m < T) { const Row x = ld_row_nt(P.in[I_X] + (size_t)m * 1024, lane); st_row_bf(mul_g(x, rs_of(row_ss(x)), ld_row(P.in[I_F1G], lane)), HN + (size_t)m * 1024, lane, (LAS unsigned char*)nullptr); }
        else { const int mm = m - T; const Row x = ld_row(P.in[I_MEM] + (size_t)mm * 1024, lane); st_row_bf(mul_g(x, rs_of(row_ss(x)), ld_row(P.in[I_MEMG], lane)), MEMN + (size_t)mm * 1024, lane, (LAS unsigned char*)nullptr); }
    }
}

constexpr int MKV_KC = 128, MKV_NCH = 1024 / MKV_KC, MKV_PITCH = MKV_KC * 2 + 16, MKV_A = 64 * MKV_PITCH, MKV_STAGE = 192 * MKV_PITCH, MKV_NP = 192 * (MKV_KC / 8) / 512;
__device__ __forceinline__ void memkv_tile(const Ptrs& P, LAS unsigned char* lds, int wave, int lane) {
    unsigned char* ws = P.ws;
    const bf16_t* MEMN = (const bf16_t*)(ws + WS_MEMN); const bf16_t* W = (const bf16_t*)(ws + WS_WMKV);
    bf16_t* KM = (bf16_t*)(ws + WS_KM); bf16_t* VMT = (bf16_t*)(ws + WS_VMT);
    const int li = lane & 31, hh = lane >> 5, tid = threadIdx.x;
    for (int tile = blockIdx.x; tile < 256; tile += gridDim.x) {
        const int tm = tile >> 3, tn = tile & 7, m0 = 64 * tm + 32 * (wave & 1), n0 = 128 * tn + 32 * (wave >> 1);
        const bf16_t* src[MKV_NP]; unsigned dst[MKV_NP];
#pragma unroll
        for (int j = 0; j < MKV_NP; ++j) { const int p = tid + 512 * j, row = p / (MKV_KC / 8), c16 = p % (MKV_KC / 8);
            src[j] = (row < 64 ? MEMN + (size_t)(64 * tm + row) * 1024 : W + (size_t)(128 * tn + row - 64) * 1024) + 8 * c16;
            dst[j] = (unsigned)(row * MKV_PITCH + 16 * c16); }
        u32x4 r[MKV_NP];
#pragma unroll
        for (int j = 0; j < MKV_NP; ++j) r[j] = *(const u32x4*)(src[j]);
#pragma unroll
        for (int j = 0; j < MKV_NP; ++j) *(LAS u32x4*)(lds + dst[j]) = r[j];
        __syncthreads();
        f32x16 acc; for (int i = 0; i < 16; ++i) acc[i] = 0.f;
        const unsigned ao = (unsigned)((32 * (wave & 1) + li) * MKV_PITCH + 16 * hh), wo = (unsigned)(MKV_A + (32 * (wave >> 1) + li) * MKV_PITCH + 16 * hh);
#pragma unroll 1
        for (int kc = 0; kc < MKV_NCH; ++kc) {
            LAS unsigned char* cur = lds + (kc & 1) * MKV_STAGE; LAS unsigned char* nxt = lds + ((kc + 1) & 1) * MKV_STAGE;
            if (kc + 1 < MKV_NCH) {
#pragma unroll
                for (int j = 0; j < MKV_NP; ++j) r[j] = *(const u32x4*)(src[j] + MKV_KC * (kc + 1)); }
#pragma unroll
            for (int st = 0; st < MKV_KC / 16; ++st) { const bf16x8 af = *(const LAS bf16x8*)(cur + ao + 32 * st), wf = *(const LAS bf16x8*)(cur + wo + 32 * st);
                acc = tn < 4 ? mfma32(wf, af, acc) : mfma32(af, wf, acc); }
            if (kc + 1 < MKV_NCH) {
#pragma unroll
                for (int j = 0; j < MKV_NP; ++j) *(LAS u32x4*)(nxt + dst[j]) = r[j]; }
            __syncthreads();
        }
        if (tn < 4) {
            const int m = m0 + li, b = m >> 8, key = m & 255, h = n0 >> 7;
#pragma unroll
            for (int rr = 0; rr < 4; ++rr) { const int d0 = (n0 & 127) + 8 * rr + 4 * hh;
                u32x2 w; w.x = cvt_pk_bf16_c(acc[4 * rr], acc[4 * rr + 1]); w.y = cvt_pk_bf16_c(acc[4 * rr + 2], acc[4 * rr + 3]);
                *(u32x2*)(KM + ((size_t)((b * 4 + h) * 256 + key)) * 128 + d0) = w; }
        } else {
            const int nn = n0 + li - 512, h = nn >> 7, dv = nn & 127;
#pragma unroll
            for (int rr = 0; rr < 4; ++rr) { const int m = m0 + 8 * rr + 4 * hh, b = m >> 8, key = m & 255;
                u32x2 w; w.x = cvt_pk_bf16_c(acc[4 * rr], acc[4 * rr + 1]); w.y = cvt_pk_bf16_c(acc[4 * rr + 2], acc[4 * rr + 3]);
                *(u32x2*)(VMT + ((size_t)((b * 4 + h) * 128 + dv)) * 256 + key) = w; }
        }
    }
}
constexpr int PR_WF = 0, PR_WFP = 2064, PR_ROWS = 16 * 2064;
struct Row2 { Row y[2], x[2]; };
template <int MODE> __device__ __forceinline__ void row_pass(const Ptrs& P, LAS unsigned char* lds, int wave, int lane) {
    unsigned char* ws = P.ws;
    const bf16_t* Yb = (const bf16_t*)(ws + WS_A2); bf16_t* HN = (bf16_t*)(ws + WS_HN);
    const float* xin = P.in[I_X];
    bf16_t* X1B = (bf16_t*)P.out; bf16_t* X2B = (bf16_t*)(ws + WS_A2 + (size_t)64 * MiB);
    const bf16_t* xb = MODE == 2 ? X1B : X2B;
    const Row gp = ld_row(P.in[MODE == 1 ? I_F1PG : (MODE == 2 ? I_MIXPG : I_F2PG)], lane), gn = ld_row(P.in[MODE == 1 ? I_MIXG : (MODE == 2 ? I_F2G : I_FING)], lane);
    const float sc = MODE == 2 ? 1.0f : 0.5f;
    bf16_t* FLOW = (bf16_t*)(ws + WS_FLOW);
    LAS unsigned char* rimg = lds + PR_ROWS + wave * 4096;
    const int fr = lane & 15, fq = lane >> 4;
    if (MODE == 1) {
        const u32x4* src = (const u32x4*)(ws + WS_WF);
        for (int i = threadIdx.x; i < 2048; i += NTHREADS) *(LAS u32x4*)(lds + PR_WF + (i >> 7) * PR_WFP + 16 * (i & 127)) = src[i];
        __syncthreads();
    }
    const int gw = blockIdx.x * 8 + wave, NGW = gridDim.x * 8, NIT = T / 2;
    Row2 cur, nxt;
#pragma unroll
    for (int i = 0; i < 2; ++i) { const size_t row = (size_t)gw * 2 + i; cur.y[i] = ld_row_bf(Yb + row * 1024, lane); cur.x[i] = MODE == 1 ? ld_row_nt(xin + row * 1024, lane) : ld_row_bf(xb + row * 1024, lane); }
    for (int item = gw; item < NIT; item += NGW) {
        const int ni = item + NGW < NIT ? item + NGW : item;
#pragma unroll
        for (int i = 0; i < 2; ++i) { const size_t row = (size_t)ni * 2 + i; nxt.y[i] = ld_row_bf(Yb + row * 1024, lane); nxt.x[i] = MODE == 1 ? ld_row_nt(xin + row * 1024, lane) : ld_row_bf(xb + row * 1024, lane); }
#pragma unroll
        for (int i = 0; i < 2; ++i) { const size_t row = (size_t)item * 2 + i;
            const float rsy = rs_of(row_ss(cur.y[i])) * sc;
#pragma unroll
            for (int j = 0; j < 4; ++j) cur.x[i].v[j] = cur.x[i].v[j] + cur.y[i].v[j] * rsy * gp.v[j];
            const Row h = mul_g(cur.x[i], rs_of(row_ss(cur.x[i])), gn);
            if (MODE == 3) st_row_nt(P.out + row * 1024, lane, h);
            else { st_row_bf_nt(cur.x[i], (MODE == 1 ? X1B : X2B) + row * 1024, lane); st_row_bf(h, HN + row * 1024, lane, MODE == 1 ? rimg + i * 2048 : (LAS unsigned char*)nullptr); }
        }
        if (MODE == 1) {
            asm volatile("s_waitcnt lgkmcnt(0)" ::: "memory");
            f32x4 a = (f32x4){0.f, 0.f, 0.f, 0.f};
#pragma unroll 8
            for (int s2 = 0; s2 < 32; ++s2) { const int k = 32 * s2 + 8 * fq;
                const bf16x8 hf = *(const LAS bf16x8*)(rimg + (fr & 1) * 2048 + k * 2);
                const bf16x8 wf = *(const LAS bf16x8*)(lds + PR_WF + fr * PR_WFP + k * 2);
                a = mfma16(wf, hf, a); }
            if (fr < 2) { u32x2 o; o.x = cvt_pk_bf16_c(a[0], a[1]); o.y = cvt_pk_bf16_c(a[2], a[3]); *(u32x2*)(FLOW + ((size_t)item * 2 + fr) * 16 + 4 * fq) = o; }
            asm volatile("s_waitcnt lgkmcnt(0)" ::: "memory");
        }
        cur = nxt;
    }
}

constexpr int GSTG = 41472, G_KB = 0, G_QB = 16384, G_VB = 32768, G_DB = 40960;
__device__ __forceinline__ void gla_block(const Ptrs& P, LAS unsigned char* lds, int bh, int vq, int wave, int lane) {
    unsigned char* ws = P.ws;
    const int b = bh >> 2, h = bh & 3, li = lane & 15, g = lane >> 4, vg = wave & 3, th = wave >> 2, j16 = 4 * vq + vg;
    const bf16_t* KTb = (const bf16_t*)(ws + WS_KT) + (size_t)bh * 64 * 8192;
    const bf16_t* Qb = (const bf16_t*)(ws + WS_Q) + (size_t)b * SEQ * 512 + h * 128;
    const bf16_t* VTb = (const bf16_t*)(ws + WS_VT) + ((size_t)bh * 64 * 256 + 64 * vq) * 64;
    const float* DCb = (const float*)(ws + WS_DEC) + (size_t)b * 64 * 512 + h * 128;
    float* OSS = (float*)(ws + WS_OSS);
    const int col = h * 256 + 16 * j16 + 4 * g;
    const f32x4 gn = *(const f32x4*)(P.in[I_GLAG] + col);
    bf16_t* arow = (bf16_t*)(ws + WS_A2) + ((size_t)b * SEQ + 32 * th + li) * 2048 + col;
    unsigned ksrc[2], qsrc[2];
#pragma unroll
    for (int i = 0; i < 2; ++i) { const int q = 2 * wave + i;
        { const int kk = 8 * q + (lane >> 3), lc = (lane & 7) ^ (kk & 7); ksrc[i] = (unsigned)(kk * 64 + lc * 8); }
        { const int t = 4 * q + (lane >> 4), l16 = (lane & 15) ^ (t & 15); qsrc[i] = (unsigned)(t * 512 + l16 * 8); } }
    unsigned vsrc; { const int vr = 8 * wave + (lane >> 3), lc = (lane & 7) ^ (vr & 7); vsrc = (unsigned)(vr * 64 + lc * 8); }
    const unsigned dsrc = (unsigned)((wave & 1) * 64 + lane);
#define GLA_ISSUE(cc, stg) do { const int _c = (cc); LAS unsigned char* _sb = lds + (stg) * GSTG; \
        const bf16_t* _kp = KTb + (size_t)_c * 8192; const bf16_t* _qp = Qb + (size_t)_c * 32768; const bf16_t* _vp = VTb + (size_t)_c * 16384; \
        _Pragma("unroll") for (int _i = 0; _i < 2; ++_i) __builtin_amdgcn_global_load_lds((const unsigned*)(_kp + ksrc[_i]), (LAS unsigned*)(_sb + G_KB + 1024 * (2 * wave + _i)), 16, 0, 0); \
        _Pragma("unroll") for (int _i = 0; _i < 2; ++_i) __builtin_amdgcn_global_load_lds((const unsigned*)(_qp + qsrc[_i]), (LAS unsigned*)(_sb + G_QB + 1024 * (2 * wave + _i)), 16, 0, 0); \
        __builtin_amdgcn_global_load_lds((const unsigned*)(_vp + vsrc), (LAS unsigned*)(_sb + G_VB + 1024 * wave), 16, 0, 0); \
        __builtin_amdgcn_global_load_lds((const unsigned*)(DCb + (size_t)_c * 512 + dsrc), (LAS unsigned*)(_sb + G_DB + (wave & 1) * 256), 4, 0, 0); } while (0)
    const int kx = li & 7;
    unsigned ka[2], va[2], qa[4], qb[4];
#pragma unroll
    for (int st = 0; st < 2; ++st) { ka[st] = (unsigned)(G_KB + li * 128 + (((4 * st + g) ^ kx) * 16)); va[st] = (unsigned)(G_VB + (16 * vg + li) * 128 + (((4 * st + g) ^ kx) * 16)); }
#pragma unroll
    for (int p = 0; p < 4; ++p) { const int ph = (4 * p + (g >> 1)) ^ li; qa[p] = (unsigned)(G_QB + li * 256 + ph * 16 + 8 * (g & 1)); qb[p] = (unsigned)(G_QB + li * 256 + (ph ^ 2) * 16 + 8 * (g & 1)); }
    const unsigned da = (unsigned)(G_DB + 16 * g);
    f32x4 S[8];
#pragma unroll
    for (int m = 0; m < 8; ++m) S[m] = (f32x4){0.f, 0.f, 0.f, 0.f};
    u32x2 oprev[2]; float sprev[2];
    oprev[0] = (u32x2){0u, 0u}; oprev[1] = (u32x2){0u, 0u}; sprev[0] = 0.f; sprev[1] = 0.f;
    u32x2 gA0, gA1, gB0, gB1;
    GLA_ISSUE(0, 0);
    { const bf16_t* gp0 = arow; const bf16_t* gp1 = gp0 + (size_t)16 * 2048;
      asm volatile("global_load_dwordx2 %0, %1, off" : "=v"(gA0) : "v"(gp0) : "memory");
      asm volatile("global_load_dwordx2 %0, %1, off" : "=v"(gA1) : "v"(gp1) : "memory"); }
    GLA_ISSUE(1, 1);
#define GLA_CHUNK(c, CUR0, CUR1, NXT0, NXT1) do { \
        asm volatile("s_waitcnt vmcnt(8)" ::: "memory");              \
        __builtin_amdgcn_s_barrier();                                 \
        asm volatile("" ::: "memory"); \
        if ((c) > 0) {                                                \
            _Pragma("unroll") for (int j = 0; j < 2; ++j) { bf16_t* ap = arow + (size_t)(((c) - 1) * 64 + 16 * j) * 2048; *(u32x2*)ap = oprev[j]; \
                if (g == 0) OSS[(((size_t)b * SEQ + ((c) - 1) * 64 + 32 * th + 16 * j + li) * 4 + h) * 16 + j16] = sprev[j]; } } \
        { const int cg = (c) + 1 < 64 ? (c) + 1 : 63; const bf16_t* gp0 = arow + (size_t)(cg * 64) * 2048; const bf16_t* gp1 = gp0 + (size_t)16 * 2048;     \
          asm volatile("global_load_dwordx2 %0, %1, off" : "=v"(NXT0) : "v"(gp0) : "memory"); \
          asm volatile("global_load_dwordx2 %0, %1, off" : "=v"(NXT1) : "v"(gp1) : "memory"); } \
        { const int cn = (c) + 2 < 64 ? (c) + 2 : 63; const int sn = ((c) + 2) % 3; GLA_ISSUE(cn, sn); } \
        LAS unsigned char* sbp = lds + ((c) % 3) * GSTG; \
        const bf16x8 vf0 = *(const LAS bf16x8*)(sbp + va[0]), vf1 = *(const LAS bf16x8*)(sbp + va[1]); \
        _Pragma("unroll") for (int m = 0; m < 8; ++m) { const f32x4 dc = *(const LAS f32x4*)(sbp + da + m * 64); S[m] = S[m] * dc; \
            S[m] = mfma16(*(const LAS bf16x8*)(sbp + ka[0] + m * 2048), vf0, S[m]); S[m] = mfma16(*(const LAS bf16x8*)(sbp + ka[1] + m * 2048), vf1, S[m]); } \
        bf16x8 sb[4]; \
        _Pragma("unroll") for (int p = 0; p < 4; ++p) { u32x4 w; w.x = cvt_pk_bf16_c(S[2 * p][0], S[2 * p][1]); w.y = cvt_pk_bf16_c(S[2 * p][2], S[2 * p][3]); \
            w.z = cvt_pk_bf16_c(S[2 * p + 1][0], S[2 * p + 1][1]); w.w = cvt_pk_bf16_c(S[2 * p + 1][2], S[2 * p + 1][3]); sb[p] = as_bf16x8(w); } \
        f32x4 o[2]; \
        _Pragma("unroll") for (int j = 0; j < 2; ++j) { const int tt = 2 * th + j; \
            o[j] = (f32x4){0.f, 0.f, 0.f, 0.f}; \
            _Pragma("unroll") for (int p = 0; p < 4; ++p) o[j] = mfma16(sb[p], cat8(*(const LAS s16x4*)(sbp + qa[p] + tt * 4096), *(const LAS s16x4*)(sbp + qb[p] + tt * 4096)), o[j]); } \
        asm volatile("s_waitcnt vmcnt(14)" : "+v"(CUR0), "+v"(CUR1) :: "memory");       \
        __builtin_amdgcn_sched_barrier(0); \
        _Pragma("unroll") for (int j = 0; j < 2; ++j) { const u32x2 gw = j ? CUR1 : CUR0; \
            float ss = (o[j][0] * o[j][0] + o[j][1] * o[j][1]) + (o[j][2] * o[j][2] + o[j][3] * o[j][3]); \
            ss = add_xor16(ss); ss = add_xor32(ss); \
            sprev[j] = ss; \
            oprev[j].x = cvt_pk_bf16(o[j][0] * bflo(gw.x) * gn[0], o[j][1] * bfhi(gw.x) * gn[1]); oprev[j].y = cvt_pk_bf16(o[j][2] * bflo(gw.y) * gn[2], o[j][3] * bfhi(gw.y) * gn[3]); } \
    } while (0)
#pragma unroll 1
    for (int c = 0; c < 64; c += 2) { GLA_CHUNK(c, gA0, gA1, gB0, gB1); GLA_CHUNK(c + 1, gB0, gB1, gA0, gA1); }
#undef GLA_CHUNK
    asm volatile("s_waitcnt vmcnt(0)" ::: "memory");
    __builtin_amdgcn_s_barrier();
    asm volatile("" ::: "memory");
#pragma unroll
    for (int j = 0; j < 2; ++j) { bf16_t* ap = arow + (size_t)(63 * 64 + 16 * j) * 2048; *(u32x2*)ap = oprev[j];
        if (g == 0) OSS[(((size_t)b * SEQ + 63 * 64 + 32 * th + 16 * j + li) * 4 + h) * 16 + j16] = sprev[j]; }
#undef GLA_ISSUE
}
__device__ __forceinline__ void xattn_unit(const Ptrs& P, int b, int h, int t0, int lane) {
    unsigned char* ws = P.ws;
    const bf16_t* XQ = (const bf16_t*)(ws + WS_XQ); bf16_t* A2 = (bf16_t*)(ws + WS_A2);
    const bf16_t* kmb = (const bf16_t*)(ws + WS_KM) + (size_t)(b * 4 + h) * 256 * 128; const bf16_t* vmb = (const bf16_t*)(ws + WS_VMT) + (size_t)(b * 4 + h) * 128 * 256;
    const int li = lane & 31, hh = lane >> 5;
    bf16x8 qf[8];
#pragma unroll
    for (int st = 0; st < 8; ++st) qf[st] = ld16(XQ + (size_t)(t0 + li) * 512 + h * 128 + 16 * st + 8 * hh);
    f32x16 X[8];
#pragma unroll
    for (int kt = 0; kt < 8; ++kt) {
#pragma unroll
        for (int i = 0; i < 16; ++i) X[kt][i] = 0.f;
#pragma unroll
        for (int st = 0; st < 8; ++st) X[kt] = mfma32(ld16(kmb + (size_t)(32 * kt + li) * 128 + 16 * st + 8 * hh), qf[st], X[kt]);
    }
    float mx = -3.0e38f;
#pragma unroll
    for (int kt = 0; kt < 8; ++kt)
#pragma unroll
        for (int i = 0; i < 16; ++i) mx = fmaxf(mx, X[kt][i]);
    mx = fmaxf(mx, __shfl_xor(mx, 32));
    float sum = 0.f;
#pragma unroll
    for (int kt = 0; kt < 8; ++kt)
#pragma unroll
        for (int i = 0; i < 16; ++i) { const float e = ex2(X[kt][i] - mx); X[kt][i] = e; sum += e; }
    sum += __shfl_xor(sum, 32);
    const float inv = 1.f / sum;
    bf16x8 pf[8][2];
#pragma unroll
    for (int kt = 0; kt < 8; ++kt)
#pragma unroll
        for (int s2 = 0; s2 < 2; ++s2) {
            u32x4 w; w.x = cvt_pk_bf16_c(X[kt][8 * s2 + 0], X[kt][8 * s2 + 1]); w.y = cvt_pk_bf16_c(X[kt][8 * s2 + 2], X[kt][8 * s2 + 3]);
            w.z = cvt_pk_bf16_c(X[kt][8 * s2 + 4], X[kt][8 * s2 + 5]); w.w = cvt_pk_bf16_c(X[kt][8 * s2 + 6], X[kt][8 * s2 + 7]);
            pf[kt][s2] = as_bf16x8(w); }
    bf16_t* orow = A2 + (size_t)(t0 + li) * 2048 + 1536 + h * 128 + 4 * hh;
#pragma unroll
    for (int nt = 0; nt < 4; ++nt) {
        f32x16 O;
#pragma unroll
        for (int i = 0; i < 16; ++i) O[i] = 0.f;
        const bf16_t* vr = vmb + (size_t)(32 * nt + li) * 256 + 4 * hh;
#pragma unroll
        for (int kt = 0; kt < 8; ++kt)
#pragma unroll
            for (int s2 = 0; s2 < 2; ++s2) O = mfma32(cat8(*(const s16x4*)(vr + 32 * kt + 16 * s2), *(const s16x4*)(vr + 32 * kt + 16 * s2 + 8)), pf[kt][s2], O);
#pragma unroll
        for (int rr = 0; rr < 4; ++rr) { u32x2 w; w.x = cvt_pk_bf16(O[4 * rr] * inv, O[4 * rr + 1] * inv); w.y = cvt_pk_bf16(O[4 * rr + 2] * inv, O[4 * rr + 3] * inv);
            *(u32x2*)(orow + 32 * nt + 8 * rr) = w; }
        asm volatile("" ::: "memory");
    }
}
__device__ __forceinline__ void xattn_unit_lds(const Ptrs& P, LAS unsigned char* lds, int h, int t0, int lane) {
    unsigned char* ws = P.ws;
    const bf16_t* XQ = (const bf16_t*)(ws + WS_XQ); bf16_t* A2 = (bf16_t*)(ws + WS_A2);
    const int li = lane & 31, hh = lane >> 5;
    bf16x8 qf[8];
#pragma unroll
    for (int st = 0; st < 8; ++st) qf[st] = ld16(XQ + (size_t)(t0 + li) * 512 + h * 128 + 16 * st + 8 * hh);
    f32x16 X[8];
    const unsigned kb = (unsigned)(li * 256), kx = (unsigned)(li & 15);
#pragma unroll
    for (int kt = 0; kt < 8; ++kt) {
#pragma unroll
        for (int i = 0; i < 16; ++i) X[kt][i] = 0.f;
#pragma unroll
        for (int st = 0; st < 8; ++st) X[kt] = mfma32(*(const LAS bf16x8*)(lds + kt * 8192 + kb + (((unsigned)(2 * st + hh) ^ kx) * 16)), qf[st], X[kt]);
    }
    float mx = -3.0e38f;
#pragma unroll
    for (int kt = 0; kt < 8; ++kt)
#pragma unroll
        for (int i = 0; i < 16; ++i) mx = fmaxf(mx, X[kt][i]);
    mx = fmaxf(mx, __shfl_xor(mx, 32));
    float sum = 0.f;
#pragma unroll
    for (int kt = 0; kt < 8; ++kt)
#pragma unroll
        for (int i = 0; i < 16; ++i) { const float e = ex2(X[kt][i] - mx); X[kt][i] = e; sum += e; }
    sum += __shfl_xor(sum, 32);
    const float inv = 1.f / sum;
    bf16x8 pf[8][2];
#pragma unroll
    for (int kt = 0; kt < 8; ++kt)
#pragma unroll
        for (int s2 = 0; s2 < 2; ++s2) {
            u32x4 w; w.x = cvt_pk_bf16_c(X[kt][8 * s2 + 0], X[kt][8 * s2 + 1]); w.y = cvt_pk_bf16_c(X[kt][8 * s2 + 2], X[kt][8 * s2 + 3]);
            w.z = cvt_pk_bf16_c(X[kt][8 * s2 + 4], X[kt][8 * s2 + 5]); w.w = cvt_pk_bf16_c(X[kt][8 * s2 + 6], X[kt][8 * s2 + 7]);
            pf[kt][s2] = as_bf16x8(w); }
    bf16_t* orow = A2 + (size_t)(t0 + li) * 2048 + 1536 + h * 128 + 4 * hh;
    const unsigned vx = (unsigned)li;
#pragma unroll
    for (int nt = 0; nt < 4; ++nt) {
        f32x16 O;
#pragma unroll
        for (int i = 0; i < 16; ++i) O[i] = 0.f;
        const unsigned vb = 65536u + (unsigned)((32 * nt + li) * 512) + 8u * (unsigned)hh;
#pragma unroll
        for (int kt = 0; kt < 8; ++kt)
#pragma unroll
            for (int s2 = 0; s2 < 2; ++s2) { const unsigned c0 = (unsigned)(4 * kt + 2 * s2);
                O = mfma32(cat8(*(const LAS s16x4*)(lds + vb + ((c0 ^ vx) * 16)), *(const LAS s16x4*)(lds + vb + (((c0 + 1) ^ vx) * 16))), pf[kt][s2], O); }
#pragma unroll
        for (int rr = 0; rr < 4; ++rr) { u32x2 w; w.x = cvt_pk_bf16(O[4 * rr] * inv, O[4 * rr + 1] * inv); w.y = cvt_pk_bf16(O[4 * rr + 2] * inv, O[4 * rr + 3] * inv);
            *(u32x2*)(orow + 32 * nt + 8 * rr) = w; }
        asm volatile("" ::: "memory");
    }
}
__device__ __forceinline__ void xattn_task(const Ptrs& P, LAS unsigned char* lds, int bh, int qtr, int wave, int lane) {
    unsigned char* ws = P.ws;
    const bf16_t* kmb = (const bf16_t*)(ws + WS_KM) + (size_t)bh * 256 * 128; const bf16_t* vmb = (const bf16_t*)(ws + WS_VMT) + (size_t)bh * 128 * 256;
    asm volatile("" : "+v"(lane));
#pragma unroll
    for (int i = 0; i < 8; ++i) { const int q = 8 * wave + i;
        const int row = 4 * q + (lane >> 4), lc = (lane & 15) ^ (row & 15);
        __builtin_amdgcn_global_load_lds((const unsigned*)(kmb + (size_t)row * 128 + lc * 8), (LAS unsigned*)(lds + 1024 * q), 16, 0, 0); }
#pragma unroll
    for (int i = 0; i < 8; ++i) { const int q = 8 * wave + i;
        const int row = 2 * q + (lane >> 5), lc = (lane & 31) ^ (row & 31);
        __builtin_amdgcn_global_load_lds((const unsigned*)(vmb + (size_t)row * 256 + lc * 8), (LAS unsigned*)(lds + 65536 + 1024 * q), 16, 0, 0); }
    asm volatile("s_waitcnt vmcnt(0)" ::: "memory");
    __syncthreads();
    const int b = bh >> 2, h = bh & 3;
#pragma unroll 1
    for (int it = 0; it < 4; ++it) { xattn_unit_lds(P, lds, h, b * SEQ + qtr * 1024 + it * 256 + wave * 32, lane); asm volatile("" ::: "memory"); }
    __syncthreads();
}
constexpr int POOL_PITCH = 272, POOL_WSCR = 48 * POOL_PITCH;
template <int G> __device__ __forceinline__ void pool_unit_g(const Ptrs& P, LAS unsigned char* sc, int t0, int lane) {
    constexpr int W = 2 << G, NR = W + 31, NP = NR * 16, NL = (NP + 63) / 64;
    unsigned char* ws = P.ws;
    const bf16_t* PIN = (const bf16_t*)(ws + WS_PIN); const bf16_t* WP = (const bf16_t*)(ws + WS_WPOOL) + G * 16384; bf16_t* A2 = (bf16_t*)(ws + WS_A2);
    const float* pscale = P.in[I_PSCALE] + G * 128;
    const int li = lane & 31, hh = lane >> 5, t = t0 + li, pos = t & (SEQ - 1), cnt = (pos + 1 < W) ? pos + 1 : W;
    const float icnt = 1.f / (float)cnt;
    { const int seq0 = t0 & ~(SEQ - 1);
      u32x4 v[NL];
#pragma unroll
      for (int i = 0; i < NL; ++i) { const int q = lane + 64 * i, j = q >> 4, c = q & 15; int r = t0 - (W - 1) + j; r = r < seq0 ? seq0 : r;
          if (q < NP) v[i] = *(const u32x4*)(PIN + (size_t)r * 512 + G * 128 + 8 * c); }
#pragma unroll
      for (int i = 0; i < NL; ++i) { const int q = lane + 64 * i, j = q >> 4, c = q & 15;
          if (q < NP) *(LAS u32x4*)(sc + j * POOL_PITCH + c * 16) = v[i]; }
      asm volatile("s_waitcnt lgkmcnt(0)" ::: "memory"); }
    f32x16 Dd[4];
#pragma unroll
    for (int nt = 0; nt < 4; ++nt)
#pragma unroll
        for (int i = 0; i < 16; ++i) Dd[nt][i] = 0.f;
    const LAS unsigned char* rowp = sc + (li + W - 1) * POOL_PITCH + 16 * hh;
#pragma unroll
    for (int st = 0; st < 8; ++st) {
        bf16x8 wq[4];
#pragma unroll
        for (int nt = 0; nt < 4; ++nt) wq[nt] = ld16(WP + (size_t)(32 * nt + li) * 128 + 16 * st + 8 * hh);
        float a[8] = {0.f, 0.f, 0.f, 0.f, 0.f, 0.f, 0.f, 0.f};
        const u32x4 own = *(const LAS u32x4*)(rowp + 32 * st);
#pragma unroll
        for (int i = 0; i < W; ++i) { const u32x4 x = *(const LAS u32x4*)(rowp + 32 * st - (i < cnt ? i : 0) * POOL_PITCH); const float wgt = (i < cnt) ? 1.f : 0.f;
            a[0] += wgt * bflo(x.x); a[1] += wgt * bfhi(x.x); a[2] += wgt * bflo(x.y); a[3] += wgt * bfhi(x.y);
            a[4] += wgt * bflo(x.z); a[5] += wgt * bfhi(x.z); a[6] += wgt * bflo(x.w); a[7] += wgt * bfhi(x.w); }
        u32x4 mw;
        mw.x = cvt_pk_bf16(a[0] * icnt - bflo(own.x), a[1] * icnt - bfhi(own.x)); mw.y = cvt_pk_bf16(a[2] * icnt - bflo(own.y), a[3] * icnt - bfhi(own.y));
        mw.z = cvt_pk_bf16(a[4] * icnt - bflo(own.z), a[5] * icnt - bfhi(own.z)); mw.w = cvt_pk_bf16(a[6] * icnt - bflo(own.w), a[7] * icnt - bfhi(own.w));
        asm volatile("s_nop 3" : "+v"(mw));
        const bf16x8 mf = as_bf16x8(mw);
#pragma unroll
        for (int nt = 0; nt < 4; ++nt) Dd[nt] = mfma32(wq[nt], mf, Dd[nt]);
    }
    asm volatile("s_waitcnt lgkmcnt(0)" ::: "memory");
    bf16_t* orow = A2 + (size_t)t * 2048 + 1024 + G * 128 + 4 * hh;
#pragma unroll
    for (int nt = 0; nt < 4; ++nt)
#pragma unroll
        for (int rr = 0; rr < 4; ++rr) { const f32x4 scv = *(const f32x4*)(pscale + 32 * nt + 8 * rr + 4 * hh);
            u32x2 o; o.x = cvt_pk_bf16(Dd[nt][4 * rr] * scv[0], Dd[nt][4 * rr + 1] * scv[1]); o.y = cvt_pk_bf16(Dd[nt][4 * rr + 2] * scv[2], Dd[nt][4 * rr + 3] * scv[3]);
            *(u32x2*)(orow + 32 * nt + 8 * rr) = o; }
}
__device__ __forceinline__ void gla_rfac_rows(const Ptrs& P) {
    const float* OSS = (const float*)(P.ws + WS_OSS); f32x4* RR = (f32x4*)(P.ws + WS_DEC);
    if (threadIdx.x < 128) for (int row = blockIdx.x * 128 + threadIdx.x; row < T; row += gridDim.x * 128) {
        float r[4];
#pragma unroll
        for (int h = 0; h < 4; ++h) { const float* op = OSS + ((size_t)row * 4 + h) * 16;
            const f32x4 s0 = *(const f32x4*)op, s1 = *(const f32x4*)(op + 4), s2 = *(const f32x4*)(op + 8), s3 = *(const f32x4*)(op + 12);
            const f32x4 s = (s0 + s1) + (s2 + s3);
            r[h] = rsqrtf(((s[0] + s[1]) + (s[2] + s[3])) * (1.f / 256.f) + EPS); }
        RR[row] = (f32x4){r[0] / r[1], r[1] / r[2], r[2] / r[3], r[3]};
    }
}

constexpr int CW_QUEUE = 12288;
__device__ __forceinline__ void p5_mixers(const Ptrs& P, LAS unsigned char* lds, int wave, int lane) {
    int gidx;
    if (gridDim.x == 256) { const int bx = (int)blockIdx.x;
        gidx = ((bx >> 3) & 1) == 0 ? (((bx & 7) * 4 + ((bx >> 4) >> 2)) * 4 + ((bx >> 4) & 3)) : -1; }
    else gidx = (int)blockIdx.x < 128 ? (int)blockIdx.x : -1;
    if (gidx >= 0) gla_block(P, lds, gidx >> 2, gidx & 3, wave, lane);
    unsigned* qh = (unsigned*)(P.ws + WS_CTL) + CW_QUEUE;
    for (;;) {
        if (threadIdx.x == 0) *(LAS unsigned*)(lds + LDSCTL_OFF + 512) = __hip_atomic_fetch_add(qh, 1u, __ATOMIC_RELAXED, __HIP_MEMORY_SCOPE_AGENT);
        __syncthreads();
        const unsigned it = *(const LAS unsigned*)(lds + LDSCTL_OFF + 512);
        __syncthreads();
        if (it >= 128u) break;
        xattn_task(P, lds, (int)it >> 2, (int)it & 3, wave, lane);
    }
    asm volatile("" ::: "memory");
#define POOL_LOOP(G) for (;;) { unsigned it = 0; if (lane == 0) it = __hip_atomic_fetch_add(qh + 64 * (1 + G), 1u, __ATOMIC_RELAXED, __HIP_MEMORY_SCOPE_AGENT); \
        it = (unsigned)__builtin_amdgcn_readfirstlane((int)it); if (it >= 1024u) break; pool_unit_g<G>(P, lds + wave * POOL_WSCR, (int)it * 32, lane); } asm volatile("" ::: "memory")
    POOL_LOOP(3); POOL_LOOP(2); POOL_LOOP(1); POOL_LOOP(0);
#undef POOL_LOOP
}
#define XB_TMO      128
#define XB_XCNT(j)  (256  + 64 * (j))
#define XB_XSUB(j)  (1280 + 64 * (j))
#define XB_XGEN(j)  (2304 + 64 * (j))
#define XB_TOP      3328
#define XB_TOPGEN   3392
#define XCD_BAR_WORDS 3456
#define XB_SPIN_CAP (1u << 18)

__device__ __forceinline__ unsigned xb_ld(unsigned* p)              { return __hip_atomic_load(p, __ATOMIC_RELAXED, __HIP_MEMORY_SCOPE_AGENT); }
__device__ __forceinline__ unsigned xb_add(unsigned* p, unsigned v) { return __hip_atomic_fetch_add(p, v, __ATOMIC_RELAXED, __HIP_MEMORY_SCOPE_AGENT); }
__device__ __forceinline__ unsigned xb_xcc_id() { return (unsigned)__builtin_amdgcn_s_getreg((3 << 11) | 20) & 0xFu; }
#define XB_SPIN(cond, bar) do { unsigned _sp = 0; while (cond) { __builtin_amdgcn_s_sleep(1); \
    if ((++_sp & 255u) == 0u) { if (xb_ld(&(bar)[XB_TMO])) break; if (_sp > XB_SPIN_CAP) { atomicAdd(&(bar)[XB_TMO], 1u); break; } } } } while (0)

struct XcdBarrier {
    unsigned* bar; unsigned x;
    volatile LAS unsigned* st;
};

__device__ __forceinline__ XcdBarrier xcd_barrier_post(unsigned* bar, volatile LAS unsigned* st) {
    XcdBarrier b; b.bar = bar; b.x = xb_xcc_id(); b.st = st;
    if (threadIdx.x == 0) (void)xb_add(&bar[XB_XCNT(b.x)], 1u);
    return b;
}
__device__ __forceinline__ void xcd_barrier_complete(unsigned* bar, unsigned x, unsigned& nloc, unsigned& nx) {
    const unsigned G = gridDim.x * gridDim.y * gridDim.z;
    unsigned sum, cnt, mine, sp = 0u;
    for (;;) {
        sum = 0u; cnt = 0u; mine = 0u;
#pragma unroll
        for (unsigned j = 0; j < 16; ++j) { const unsigned c = xb_ld(&bar[XB_XCNT(j)]); sum += c; cnt += (c > 0u) ? 1u : 0u; mine = (j == x) ? c : mine; }
        if (sum == G) break;
        __builtin_amdgcn_s_sleep(1);
        if ((++sp & 255u) == 0u) { if (xb_ld(&bar[XB_TMO])) break; if (sp > XB_SPIN_CAP) { atomicAdd(&bar[XB_TMO], 1u); break; } }
    }
    nloc = mine > 0u ? mine : 1u; nx = cnt > 0u ? cnt : 1u;
}

__device__ __forceinline__ void xcd_barrier(const XcdBarrier& b) {
    asm volatile("s_waitcnt vmcnt(0)" ::: "memory");
    __syncthreads();
    if (threadIdx.x == 0) {
        unsigned* bar = b.bar;
        __builtin_amdgcn_s_waitcnt(0);
        unsigned nloc = b.st[0], nx = b.st[1];
        if (nloc == 0u) { xcd_barrier_complete(bar, b.x, nloc, nx); b.st[0] = nloc; b.st[1] = nx; }
        const unsigned old = xb_add(&bar[XB_XSUB(b.x)], 1u);
        const unsigned gen = old / nloc;
        if (old + 1u == (gen + 1u) * nloc) {
            __builtin_amdgcn_fence(__ATOMIC_RELEASE, "agent");
            asm volatile("s_waitcnt vmcnt(0)" ::: "memory");
            const unsigned og = xb_add(&bar[XB_TOP], 1u);
            const unsigned tg = og / nx;
            if (og + 1u == (tg + 1u) * nx) xb_add(&bar[XB_TOPGEN], 1u);
            else XB_SPIN(xb_ld(&bar[XB_TOPGEN]) == tg, bar);
            __builtin_amdgcn_fence(__ATOMIC_ACQUIRE, "agent");
            xb_add(&bar[XB_XGEN(b.x)], 1u);
            asm volatile("s_waitcnt vmcnt(0)" ::: "memory");
        } else {
            XB_SPIN(xb_ld(&bar[XB_XGEN(b.x)]) == gen, bar);
            __builtin_amdgcn_fence(__ATOMIC_ACQUIRE, "agent");
            asm volatile("s_waitcnt vmcnt(0)" ::: "memory");
        }
    }
    __syncthreads();
}

constexpr int NPHASE = 14;
#ifndef DBL
#define DBL -1
#endif
constexpr int DBL_PHASE = DBL;
__global__ void __launch_bounds__(NTHREADS, 2) fwd(Ptrs P) {
    extern __shared__ __attribute__((aligned(16))) unsigned char lds_raw[];
    LAS unsigned char* lds = (LAS unsigned char*)lds_raw;
    const int tid = threadIdx.x, lane = tid & 63, wave = __builtin_amdgcn_readfirstlane(tid >> 6);
    unsigned char* ws = P.ws;
    cooperative_groups::grid_group grid = cooperative_groups::this_grid();
    const int lo = P.ph_lo, hi = P.ph_hi;
    volatile LAS unsigned* MISC = (volatile LAS unsigned*)(lds + LDSCTL_OFF);
    if (tid < 64) MISC[tid] = 0u;
    __syncthreads();
    XcdBarrier bar = xcd_barrier_post((unsigned*)(ws + WS_CTL) + CW_BAR, MISC + 8);
#define IN(k) (lo <= (k) && (k) < hi)
#define SEAM(k) do { if (IN(k) && IN((k) + 1)) xcd_barrier(bar); } while (0)
    if (lo > hi) grid.sync();
    const int G = gridDim.x, c = blockIdx.x;
    bf16_t* HN = (bf16_t*)(ws + WS_HN); bf16_t* Gb = (bf16_t*)(ws + WS_M); float* Y = (float*)(ws + WS_A2); bf16_t* A2 = (bf16_t*)(ws + WS_A2);
    if (IN(0)) p0_prologue(P, lds, wave, lane);
    if constexpr (DBL_PHASE == 0) { if (IN(0)) { xcd_barrier(bar); p0_prologue(P, lds, wave, lane); } }
    SEAM(0);
    if (IN(1)) { pg8::Gemm g{HN, (const bf16_t*)(ws + WS_W1A), T, 2 * FF, D}; pg8::StaticOrder S; S.init(T, 2 * FF, G, c); EpiSwiglu E{Gb};
        pg8::gemm_phase<EpiSwiglu, pg8::StaticOrder, true, true>(lds, g, S, E); }
    if constexpr (DBL_PHASE == 1) { if (IN(1)) { xcd_barrier(bar); { pg8::Gemm g{HN, (const bf16_t*)(ws + WS_W1A), T, 2 * FF, D}; pg8::StaticOrder S; S.init(T, 2 * FF, G, c); EpiSwiglu E{Gb};
        pg8::gemm_phase<EpiSwiglu, pg8::StaticOrder, true, true>(lds, g, S, E); } } }
    SEAM(1);
    if (IN(2)) { pg8::Gemm g{Gb, (const bf16_t*)(ws + WS_W1B), T, D, FF}; pg8::StaticOrder S; S.init(T, D, G, c); EpiYbf E{(bf16_t*)Y};
        pg8::gemm_phase<EpiYbf, pg8::StaticOrder, true, true>(lds, g, S, E); }
    if constexpr (DBL_PHASE == 2) { if (IN(2)) { xcd_barrier(bar); { pg8::Gemm g{Gb, (const bf16_t*)(ws + WS_W1B), T, D, FF}; pg8::StaticOrder S; S.init(T, D, G, c); EpiYbf E{(bf16_t*)Y};
        pg8::gemm_phase<EpiYbf, pg8::StaticOrder, true, true>(lds, g, S, E); } } }
    SEAM(2);
    if (IN(3)) { memkv_tile(P, lds, wave, lane); row_pass<1>(P, lds, wave, lane); }
    if constexpr (DBL_PHASE == 3) { if (IN(3)) { xcd_barrier(bar); { memkv_tile(P, lds, wave, lane); row_pass<1>(P, lds, wave, lane); } } }
    SEAM(3);
    if (IN(4)) { pg8::Gemm g{HN, (const bf16_t*)(ws + WS_WIN), T, 4096, D}; pg8::StaticOrder S; S.init(T, 4096, G, c);
        EpiInProj E{(bf16_t*)(ws + WS_Q), (bf16_t*)(ws + WS_KT), (bf16_t*)(ws + WS_VT), A2, (bf16_t*)(ws + WS_PIN), (bf16_t*)(ws + WS_XQ), (float*)(ws + WS_DEC),
                    (const bf16_t*)(ws + WS_FLOW), (const bf16_t*)(ws + WS_WFU), P.in[I_BF]};
        pg8::gemm_phase<EpiInProj, pg8::StaticOrder, true, true>(lds, g, S, E); }
    if constexpr (DBL_PHASE == 4) { if (IN(4)) { xcd_barrier(bar); { pg8::Gemm g{HN, (const bf16_t*)(ws + WS_WIN), T, 4096, D}; pg8::StaticOrder S; S.init(T, 4096, G, c);
        EpiInProj E{(bf16_t*)(ws + WS_Q), (bf16_t*)(ws + WS_KT), (bf16_t*)(ws + WS_VT), A2, (bf16_t*)(ws + WS_PIN), (bf16_t*)(ws + WS_XQ), (float*)(ws + WS_DEC),
                    (const bf16_t*)(ws + WS_FLOW), (const bf16_t*)(ws + WS_WFU), P.in[I_BF]};
        pg8::gemm_phase<EpiInProj, pg8::StaticOrder, true, true>(lds, g, S, E); } } }
    SEAM(4);
    unsigned char* GA = (unsigned char*)P.out + ((size_t)64 << 20); unsigned char* GC = (unsigned char*)(ws + WS_GC);
    const int gate_early = (G == 256) ? 128 * P5_GATE_UNITS : 0;
    if (IN(5)) { p5_mixers(P, lds, wave, lane);
        if (G == 256 && ((c >> 3) & 1)) { __syncthreads();
            pg8::Gemm g{HN, (const bf16_t*)(ws + WS_WIN) + (size_t)4096 * 1024, T, 3072, D}; pg8::OffsetOrder S; S.init(T, 3072, 128, ((c >> 4) << 3) | (c & 7), 0, gate_early); EpiGates E{GA, GC};
            pg8::gemm_phase<EpiGates, pg8::OffsetOrder, true, true>(lds, g, S, E); } }
    SEAM(5);
    if (IN(7)) { { pg8::Gemm g{HN, (const bf16_t*)(ws + WS_WIN) + (size_t)4096 * 1024, T, 3072, D}; pg8::OffsetOrder S; S.init(T, 3072, G, c, gate_early, 1 << 30); EpiGates E{GA, GC};
        pg8::gemm_phase<EpiGates, pg8::OffsetOrder, true, true>(lds, g, S, E); }
        gla_rfac_rows(P); }
    if constexpr (DBL_PHASE == 7) { if (IN(7)) { xcd_barrier(bar); { pg8::Gemm g{HN, (const bf16_t*)(ws + WS_WIN) + (size_t)4096 * 1024, T, 3072, D}; pg8::StaticOrder S; S.init(T, 3072, G, c); EpiGates E{GA, GC};
        pg8::gemm_phase<EpiGates, pg8::StaticOrder, true, true>(lds, g, S, E); } } }
    SEAM(7);
    if (IN(8)) { pg8::Gemm g{A2, (const bf16_t*)(ws + WS_WUP), T, D, 2048}; pg8::StaticOrder S; S.init(T, D, G, c); EpiMerge E{GA, GC, HN, (const float*)(ws + WS_DEC)};
        pg8::gemm_phase<EpiMerge, pg8::StaticOrder, true, true>(lds, g, S, E); }
    if constexpr (DBL_PHASE == 8) { if (IN(8)) { xcd_barrier(bar); { pg8::Gemm g{A2, (const bf16_t*)(ws + WS_WUP), T, D, 2048}; pg8::StaticOrder S; S.init(T, D, G, c); EpiMerge E{GA, GC, HN, (const float*)(ws + WS_DEC)};
        pg8::gemm_phase<EpiMerge, pg8::StaticOrder, true, true>(lds, g, S, E); } } }
    SEAM(8);
    if (IN(9)) { pg8::Gemm g{HN, (const bf16_t*)(ws + WS_WO), T, D, D}; pg8::StaticOrder S; S.init(T, D, G, c); EpiYbf E{(bf16_t*)Y};
        pg8::gemm_phase<EpiYbf, pg8::StaticOrder, true, true>(lds, g, S, E); }
    if constexpr (DBL_PHASE == 9) { if (IN(9)) { xcd_barrier(bar); { pg8::Gemm g{HN, (const bf16_t*)(ws + WS_WO), T, D, D}; pg8::StaticOrder S; S.init(T, D, G, c); EpiYbf E{(bf16_t*)Y};
        pg8::gemm_phase<EpiYbf, pg8::StaticOrder, true, true>(lds, g, S, E); } } }
    SEAM(9);
    if (IN(10)) row_pass<2>(P, lds, wave, lane);
    SEAM(10);
    if (IN(11)) { pg8::Gemm g{HN, (const bf16_t*)(ws + WS_W2A), T, 2 * FF, D}; pg8::StaticOrder S; S.init(T, 2 * FF, G, c); EpiSwiglu E{Gb};
        pg8::gemm_phase<EpiSwiglu, pg8::StaticOrder, true, true>(lds, g, S, E); }
    if constexpr (DBL_PHASE == 11) { if (IN(11)) { xcd_barrier(bar); { pg8::Gemm g{HN, (const bf16_t*)(ws + WS_W2A), T, 2 * FF, D}; pg8::StaticOrder S; S.init(T, 2 * FF, G, c); EpiSwiglu E{Gb};
        pg8::gemm_phase<EpiSwiglu, pg8::StaticOrder, true, true>(lds, g, S, E); } } }
    SEAM(11);
    if (IN(12)) { pg8::Gemm g{Gb, (const bf16_t*)(ws + WS_W2B), T, D, FF}; pg8::StaticOrder S; S.init(T, D, G, c); EpiYbf E{(bf16_t*)Y};
        pg8::gemm_phase<EpiYbf, pg8::StaticOrder, true, true>(lds, g, S, E); }
    if constexpr (DBL_PHASE == 12) { if (IN(12)) { xcd_barrier(bar); { pg8::Gemm g{Gb, (const bf16_t*)(ws + WS_W2B), T, D, FF}; pg8::StaticOrder S; S.init(T, D, G, c); EpiYbf E{(bf16_t*)Y};
        pg8::gemm_phase<EpiYbf, pg8::StaticOrder, true, true>(lds, g, S, E); } } }
    SEAM(12);
    if (IN(13)) row_pass<3>(P, lds, wave, lane);
#undef IN
#undef SEAM
}
}
#ifndef MK_MODE
#define MK_MODE 0
#endif
#if MK_MODE == 1
namespace dbg {
using mk::bf16_t;
__device__ __forceinline__ float b2f(bf16_t u) { return __uint_as_float((unsigned)u << 16); }
template <class F> __global__ void cmp_k(F f, const float* ref, int ldr, int rows, int cols, float* slot) {
    float d = 0.f, s = 0.f;
    for (size_t i = (size_t)blockIdx.x * 256 + threadIdx.x; i < (size_t)rows * cols; i += (size_t)gridDim.x * 256) {
        const int r = (int)(i / cols), c = (int)(i % cols); const float a = f(r, c), b = ref[(size_t)r * ldr + c]; d += (a - b) * (a - b); s += b * b; }
    for (int o = 32; o > 0; o >>= 1) { d += __shfl_down(d, o); s += __shfl_down(s, o); }
    if ((threadIdx.x & 63) == 0) { atomicAdd(slot, d); atomicAdd(slot + 1, s); }
}
template <class F> inline void cmp(hipStream_t st, F f, const float* ref, int ldr, int rows, int cols, float* slots, int k) {
    hipLaunchKernelGGL(cmp_k<F>, dim3(256), dim3(256), 0, st, f, ref, ldr, rows, cols, slots + 2 * k);
}
__global__ void report(const float* slots, int n, float tol, float* out) {
    if (threadIdx.x == 0 && blockIdx.x == 0) for (int k = 0; k < n; ++k) { const float rv = slots[2 * k] / fmaxf(slots[2 * k + 1], 1e-30f); if (!(rv < tol)) { out[0] = 1000.f * (float)(k + 1); break; } }
}
__global__ void sigm_k(const float* proj, float* o, int R) { const size_t i = (size_t)blockIdx.x * 256 + threadIdx.x; if (i < (size_t)R * 3072) { const size_t t = i / 3072; const int c = (int)(i % 3072); o[i] = nv::sigm_f(proj[t * 7184 + nv::OGT + c]); } }
__global__ void silu_k(const float* proj, float* o, int R) { const size_t i = (size_t)blockIdx.x * 256 + threadIdx.x; if (i < (size_t)R * 1024) { const size_t t = i / 1024; const int c = (int)(i % 1024); o[i] = nv::silu_f(proj[t * 7184 + nv::OG + c]); } }
}
#endif

extern "C" void kernel_launch(void* const* d_in, const int* in_sizes, int n_in, void* d_out, int out_size, void* d_ws, size_t ws_size, hipStream_t stream) {
    static int grid = 0;
    if (grid == 0) {
        if (n_in != 25 || out_size != mk::T * 1024 || ws_size < mk::WS_END) { fprintf(stderr, "kernel_launch: unexpected shapes (n_in %d out %d ws %zu)\n", n_in, out_size, ws_size); grid = -1; return; }
        int dev = 0, cus = 0, per_cu = 0;
        hipGetDevice(&dev); hipDeviceGetAttribute(&cus, hipDeviceAttributeMultiprocessorCount, dev);
        if (hipFuncSetAttribute((const void*)mk::fwd, hipFuncAttributeMaxDynamicSharedMemorySize, mk::LDS_BYTES) != hipSuccess) { fprintf(stderr, "kernel_launch: hipFuncSetAttribute failed\n"); grid = -1; return; }
        hipOccupancyMaxActiveBlocksPerMultiprocessor(&per_cu, (const void*)mk::fwd, mk::NTHREADS, mk::LDS_BYTES);
        if (per_cu < 1) { fprintf(stderr, "kernel_launch: occupancy query says %d blocks/CU\n", per_cu); (void)hipGetLastError(); per_cu = 1; }
        grid = cus;
        if (grid != 256) fprintf(stderr, "kernel_launch: note: %d CUs\n", grid);
    }
    if (grid < 0) return;
    mk::Ptrs p{};
    for (int i = 0; i < 25; ++i) p.in[i] = (const float*)d_in[i];
    p.out = (float*)d_out; p.ws = (unsigned char*)d_ws;
#if MK_MODE == 0
    p.ph_lo = 0; p.ph_hi = mk::NPHASE;
    if (hipMemsetAsync((char*)d_ws + mk::WS_CTL, 0, mk::CTL_BYTES, stream) != hipSuccess) { fprintf(stderr, "kernel_launch: memset failed\n"); return; }
    void* args[] = {&p};
    hipError_t e = hipLaunchCooperativeKernel((const void*)mk::fwd, dim3(grid), dim3(mk::NTHREADS), args, mk::LDS_BYTES, stream);
    if (e != hipSuccess) fprintf(stderr, "kernel_launch: cooperative launch failed: %s\n", hipGetErrorString(e));
#else
    constexpr int BC = 5, R = 512; constexpr size_t row0 = (size_t)BC * 4096;
    unsigned char* ws = (unsigned char*)d_ws;
    hipMemsetAsync(ws + mk::WS_CTL, 0, mk::CTL_BYTES, stream);
    float* slots = (float*)(ws + mk::WS_CTL + 1024);
    nv::Bufs b; const size_t nf = nv::carve(b, (float*)(ws + mk::WS_END), R, 256);
    if (mk::WS_END + nf * 4 > ws_size) { fprintf(stderr, "debug: ws too small (%zu)\n", ws_size); return; }
    auto F = [&](int i) { return (const float*)d_in[i]; };
    auto PH = [&](int k) { p.ph_lo = k; p.ph_hi = k + 1; hipLaunchKernelGGL(mk::fwd, dim3(grid), dim3(mk::NTHREADS), mk::LDS_BYTES, stream, p); };
    using mk::bf16_t; using dbg::b2f;
    const float* x = F(0) + row0 * 1024; float* out = (float*)d_out;
    const bf16_t* HN = (const bf16_t*)(ws + mk::WS_HN); const bf16_t* Gb = (const bf16_t*)(ws + mk::WS_M); const float* Y = (const float*)(ws + mk::WS_A2);
    const bf16_t* A2 = (const bf16_t*)(ws + mk::WS_A2);
    int k = 0;
    PH(0);
    hipLaunchKernelGGL(nv::rmsnorm, dim3(R), dim3(256), 0, stream, x, 1024, F(2), b.h, 1024, 1024);
    dbg::cmp(stream, [=] __device__(int r, int c) { return b2f(HN[(row0 + r) * 1024 + c]); }, b.h, 1024, R, 1024, slots, k++);
    hipLaunchKernelGGL(nv::rmsnorm, dim3(256), dim3(256), 0, stream, F(1) + (size_t)BC * 256 * 1024, 1024, F(13), b.memn, 1024, 1024);
    { const bf16_t* MEMN = (const bf16_t*)(ws + mk::WS_MEMN);
      dbg::cmp(stream, [=] __device__(int r, int c) { return b2f(MEMN[((size_t)BC * 256 + r) * 1024 + c]); }, b.memn, 1024, 256, 1024, slots, k++); }
    PH(1);
    nv::gemm(stream, b.h, 1024, F(3), 5632, b.big, 5632, R, 5632, 1024);
    hipLaunchKernelGGL(nv::swiglu, dim3((R * 2816 + 255) / 256), dim3(256), 0, stream, b.big, b.gg, R, 2816);
    dbg::cmp(stream, [=] __device__(int r, int c) { return b2f(Gb[(row0 + r) * 2816 + c]); }, b.gg, 2816, R, 2816, slots, k++);
    PH(2);
    nv::gemm(stream, b.gg, 2816, F(4), 1024, b.y, 1024, R, 1024, 2816);
    dbg::cmp(stream, [=] __device__(int r, int c) { return Y[(row0 + r) * 1024 + c]; }, b.y, 1024, R, 1024, slots, k++);
    PH(3);
    hipLaunchKernelGGL(nv::resid_norm, dim3(R), dim3(256), 0, stream, x, b.y, F(5), 0.5f, b.xo);
    dbg::cmp(stream, [=] __device__(int r, int c) { return out[(row0 + r) * 1024 + c]; }, b.xo, 1024, R, 1024, slots, k++);
    hipLaunchKernelGGL(nv::rmsnorm, dim3(R), dim3(256), 0, stream, b.xo, 1024, F(6), b.h, 1024, 1024);
    dbg::cmp(stream, [=] __device__(int r, int c) { return b2f(HN[(row0 + r) * 1024 + c]); }, b.h, 1024, R, 1024, slots, k++);
    nv::gemm(stream, b.h, 1024, F(7), 7184, b.big, 7184, R, 7184, 1024);
    { const bf16_t* FLOW = (const bf16_t*)(ws + mk::WS_FLOW);
      dbg::cmp(stream, [=] __device__(int r, int c) { return b2f(FLOW[(row0 + r) * 16 + c]); }, b.big + nv::OF, 7184, R, 16, slots, k++); }
    nv::gemm(stream, b.memn, 1024, F(14), 1024, b.kv, 1024, 256, 1024, 1024);
    { const bf16_t* KM = (const bf16_t*)(ws + mk::WS_KM); const bf16_t* VMT = (const bf16_t*)(ws + mk::WS_VMT);
      dbg::cmp(stream, [=] __device__(int r, int c) { return b2f(KM[((size_t)(BC * 4 + (c >> 7)) * 256 + r) * 128 + (c & 127)]); }, b.kv, 1024, 256, 512, slots, k++);
      dbg::cmp(stream, [=] __device__(int r, int c) { return b2f(VMT[((size_t)(BC * 4 + (c >> 7)) * 128 + (c & 127)) * 256 + r]); }, b.kv + 512, 1024, 256, 512, slots, k++); }
    PH(4);
    hipLaunchKernelGGL(nv::gla_prep, dim3((R / 64 * 512 + 255) / 256), dim3(256), 0, stream, b.big, F(8), F(9), b.kt, b.dec, R);
    { const bf16_t* Q = (const bf16_t*)(ws + mk::WS_Q); const bf16_t* KT = (const bf16_t*)(ws + mk::WS_KT); const bf16_t* VT = (const bf16_t*)(ws + mk::WS_VT);
      const bf16_t* PIN = (const bf16_t*)(ws + mk::WS_PIN); const bf16_t* XQ = (const bf16_t*)(ws + mk::WS_XQ); const float* DEC = (const float*)(ws + mk::WS_DEC);
      dbg::cmp(stream, [=] __device__(int r, int c) { return b2f(Q[(row0 + r) * 512 + c]) * (1.f / mk::QSCALE); }, b.big + nv::OQ, 7184, R, 512, slots, k++);
      dbg::cmp(stream, [=] __device__(int r, int c) { return b2f(KT[((size_t)((BC * 4 + (c >> 7)) * 64 + (r >> 6)) * 128 + (c & 127)) * 64 + (r & 63)]); }, b.kt, 512, R, 512, slots, k++);
      dbg::cmp(stream, [=] __device__(int r, int c) { return DEC[((size_t)BC * 64 + r) * 512 + c]; }, b.dec, 512, R / 64, 512, slots, k++);
      dbg::cmp(stream, [=] __device__(int r, int c) { return b2f(VT[((size_t)((BC * 4 + (c >> 8)) * 64 + (r >> 6)) * 256 + (c & 255)) * 64 + (r & 63)]); }, b.big + nv::OV, 7184, R, 1024, slots, k++);
      hipLaunchKernelGGL(dbg::silu_k, dim3((R * 1024 + 255) / 256), dim3(256), 0, stream, b.big, b.o, R);
      dbg::cmp(stream, [=] __device__(int r, int c) { return b2f(A2[(row0 + r) * 2048 + c]); }, b.o, 1024, R, 1024, slots, k++);
      dbg::cmp(stream, [=] __device__(int r, int c) { return b2f(PIN[(row0 + r) * 512 + c]); }, b.big + nv::OP, 7184, R, 512, slots, k++);
      dbg::cmp(stream, [=] __device__(int r, int c) { return b2f(XQ[(row0 + r) * 512 + c]) * (1.f / mk::XSCALE); }, b.big + nv::OX, 7184, R, 512, slots, k++); }
    PH(5);
    hipLaunchKernelGGL(nv::gla_scan, dim3(32), dim3(256), 0, stream, b.big, b.kt, b.dec, b.o, R);
    hipLaunchKernelGGL(nv::gla_out, dim3(R), dim3(256), 0, stream, b.o, b.big, F(10), b.ga);
    hipLaunchKernelGGL(nv::pool_mix, dim3((R * 512 + 255) / 256), dim3(256), 0, stream, b.big, b.mixed, R);
    hipLaunchKernelGGL(nv::pool_lin, dim3((R * 512 + 255) / 256), dim3(256), 0, stream, b.mixed, F(11), F(12), b.py, R);
    hipLaunchKernelGGL(nv::xattn, dim3(R * 4), dim3(256), 0, stream, b.big, b.kv, b.xa);
    dbg::cmp(stream, [=] __device__(int r, int c) { return b2f(A2[(row0 + r) * 2048 + 1024 + c]); }, b.py, 512, R, 512, slots, k++);
    dbg::cmp(stream, [=] __device__(int r, int c) { return b2f(A2[(row0 + r) * 2048 + 1536 + c]); }, b.xa, 512, R, 512, slots, k++);
    PH(6);
    { const bf16_t* GT = (const bf16_t*)(ws + mk::WS_M);
      hipLaunchKernelGGL(dbg::sigm_k, dim3((R * 3072 + 255) / 256), dim3(256), 0, stream, b.big, b.ya, R);
      dbg::cmp(stream, [=] __device__(int r, int c) { return b2f(GT[(row0 + r) * 3072 + c]); }, b.ya, 3072, R, 3072, slots, k++);
      dbg::cmp(stream, [=] __device__(int r, int c) { return b2f(A2[(row0 + r) * 2048 + c]); }, b.ga, 1024, R, 1024, slots, k++); }
    PH(7);
    nv::gemm(stream, b.ga, 1024, F(15), 1024, b.ya, 1024, R, 1024, 1024);
    nv::gemm(stream, b.py, 512, F(16), 1024, b.yb, 1024, R, 1024, 512);
    nv::gemm(stream, b.xa, 512, F(17), 1024, b.yc, 1024, R, 1024, 512);
    hipLaunchKernelGGL(nv::merge, dim3((R * 1024 + 255) / 256), dim3(256), 0, stream, b.big, b.ya, b.yb, b.yc, b.mg, R);
    dbg::cmp(stream, [=] __device__(int r, int c) { return b2f(HN[(row0 + r) * 1024 + c]); }, b.mg, 1024, R, 1024, slots, k++);
    PH(8);
    nv::gemm(stream, b.mg, 1024, F(18), 1024, b.y, 1024, R, 1024, 1024);
    dbg::cmp(stream, [=] __device__(int r, int c) { return Y[(row0 + r) * 1024 + c]; }, b.y, 1024, R, 1024, slots, k++);
    PH(9);
    hipLaunchKernelGGL(nv::resid_norm, dim3(R), dim3(256), 0, stream, b.xo, b.y, F(19), 1.0f, b.xo);
    dbg::cmp(stream, [=] __device__(int r, int c) { return out[(row0 + r) * 1024 + c]; }, b.xo, 1024, R, 1024, slots, k++);
    hipLaunchKernelGGL(nv::rmsnorm, dim3(R), dim3(256), 0, stream, b.xo, 1024, F(20), b.h, 1024, 1024);
    dbg::cmp(stream, [=] __device__(int r, int c) { return b2f(HN[(row0 + r) * 1024 + c]); }, b.h, 1024, R, 1024, slots, k++);
    PH(10);
    nv::gemm(stream, b.h, 1024, F(21), 5632, b.big, 5632, R, 5632, 1024);
    hipLaunchKernelGGL(nv::swiglu, dim3((R * 2816 + 255) / 256), dim3(256), 0, stream, b.big, b.gg, R, 2816);
    dbg::cmp(stream, [=] __device__(int r, int c) { return b2f(Gb[(row0 + r) * 2816 + c]); }, b.gg, 2816, R, 2816, slots, k++);
    PH(11);
    nv::gemm(stream, b.gg, 2816, F(22), 1024, b.y, 1024, R, 1024, 2816);
    dbg::cmp(stream, [=] __device__(int r, int c) { return Y[(row0 + r) * 1024 + c]; }, b.y, 1024, R, 1024, slots, k++);
    PH(12);
    hipLaunchKernelGGL(dbg::report, dim3(1), dim3(64), 0, stream, slots, k, 2e-3f, out);
#endif
}
```
